# Optimizing an MI355X kernel written in HIP

```python
import math
import jax
import jax.numpy as jnp
from jax import lax
import numpy as np

D_MODEL = 2048
BATCH = 2
SEQ = 8192
DEPTH = 2

HEAD_DIM = 128
D_MIX = D_MODEL
N_MIX_HEADS = D_MIX // HEAD_DIM
RET_HEADS = N_MIX_HEADS // 4
GDN_HEADS = (N_MIX_HEADS - RET_HEADS) // 2
MOBA_HEADS = N_MIX_HEADS - RET_HEADS - GDN_HEADS
RET_W = RET_HEADS * HEAD_DIM
GDN_W = GDN_HEADS * HEAD_DIM
MOBA_W = MOBA_HEADS * HEAD_DIM
IN_WIDTH = 4 * RET_W + 4 * GDN_W + 2 * GDN_HEADS + 4 * MOBA_W
RET_CHUNK = 128
GDN_CHUNK = 64
GDN_CONV = 4
MOBA_BLOCK = 256
MOBA_TOP_K = 3
MOBA_Q_BLOCK = 64
RMS_EPS = 1e-6

kernel_name = 'hymba_style_retention_gdn_moba_block'


def rms_norm(x, w):
    x32 = x.astype(jnp.float32)
    y = x32 * lax.rsqrt(jnp.mean(x32 * x32, axis=-1, keepdims=True) + RMS_EPS)
    return (y * w).astype(x.dtype)


def l2_norm(x):
    x32 = x.astype(jnp.float32)
    return (x32 * lax.rsqrt(jnp.sum(x32 * x32, axis=-1, keepdims=True) + RMS_EPS)).astype(x.dtype)


def to_heads(t, n_heads):
    b, s, _ = t.shape
    return t.reshape(b, s, n_heads, -1).transpose(0, 2, 1, 3)


def from_heads(t):
    b, h, s, d = t.shape
    return t.transpose(0, 2, 1, 3).reshape(b, s, h * d)


def causal_depthwise_conv(x, w):
    k, c = w.shape
    return lax.conv_general_dilated(x, w[:, None, :].astype(x.dtype), window_strides=(1,),
                                    padding=[(k - 1, 0)], dimension_numbers=('NWC', 'WIO', 'NWC'),
                                    feature_group_count=c)


def retention(q, k, v):
    in_dtype = v.dtype
    q, k, v = (t.astype(jnp.float32) for t in (q, k, v))
    b, h, s, d = q.shape
    c = RET_CHUNK
    n = s // c
    q = q.reshape(b, h, n, c, d)
    k = k.reshape(b, h, n, c, d)
    v = v.reshape(b, h, n, c, d)
    log_gamma = jnp.log1p(-jnp.exp2(-5.0 - jnp.arange(h, dtype=jnp.float32)))[:, None]
    pos = jnp.arange(c, dtype=jnp.float32)
    diff = pos[:, None] - pos[None, :]
    decay_mat = jnp.where(diff >= 0, jnp.exp(jnp.maximum(diff, 0.0) * log_gamma[:, :, None]), 0.0)
    scores = jnp.einsum('bhncd,bhnsd->bhncs', q, k) * decay_mat[None, :, None]
    intra = jnp.einsum('bhncs,bhnse->bhnce', scores, v)
    k_w = k * jnp.exp((c - 1 - pos) * log_gamma)[None, :, None, :, None]
    kv = jnp.einsum('bhncd,bhnce->nbhde', k_w, v)
    chunk_decay = jnp.exp(c * log_gamma)[:, :, None]

    def step(state, kv_n):
        return state * chunk_decay + kv_n, state

    _, s_prev = lax.scan(step, jnp.zeros((b, h, d, d), jnp.float32), kv)
    q_w = q * jnp.exp((pos + 1.0) * log_gamma)[None, :, None, :, None]
    cross = jnp.einsum('bhncd,nbhde->bhnce', q_w, s_prev)
    return (intra + cross).reshape(b, h, s, d).astype(in_dtype)


def gated_delta_rule(q, k, v, g, beta):
    in_dtype = v.dtype
    q, k, v, g, beta = (t.astype(jnp.float32) for t in (q, k, v, g, beta))
    b, h, s, d = q.shape
    c = GDN_CHUNK
    n = s // c
    q = q.reshape(b, h, n, c, d)
    k = k.reshape(b, h, n, c, d)
    v = v.reshape(b, h, n, c, d)
    g_cum = jnp.cumsum(g.reshape(b, h, n, c), axis=-1)
    beta = beta.reshape(b, h, n, c)
    causal = jnp.tril(jnp.ones((c, c), dtype=bool))
    strict = jnp.tril(jnp.ones((c, c), dtype=bool), -1)
    decay = jnp.exp(jnp.where(causal, g_cum[..., :, None] - g_cum[..., None, :], -jnp.inf))
    k_beta = k * beta[..., None]
    m = jnp.where(strict, jnp.einsum('bhncd,bhnsd->bhncs', k_beta, k) * decay, 0.0)
    rhs = jnp.concatenate([k_beta * jnp.exp(g_cum)[..., None], v * beta[..., None]], axis=-1)
    wu = lax.linalg.triangular_solve(m + jnp.eye(c, dtype=jnp.float32), rhs, left_side=True,
                                     lower=True, unit_diagonal=True)
    w, u = wu[..., :d], wu[..., d:]
    qk = jnp.einsum('bhncd,bhnsd->bhncs', q, k) * decay
    q_g = q * jnp.exp(g_cum)[..., None]
    g_last = g_cum[..., -1]
    k_g = k * jnp.exp(g_last[..., None] - g_cum)[..., None]

    def step(state, inp):
        q_n, k_n, w_n, u_n, qk_n, gl_n = inp
        v_new = u_n - jnp.einsum('bhcd,bhde->bhce', w_n, state)
        o = jnp.einsum('bhcd,bhde->bhce', q_n, state) + jnp.einsum('bhcs,bhse->bhce', qk_n, v_new)
        state = state * jnp.exp(gl_n)[..., None, None] + jnp.einsum('bhcd,bhce->bhde', k_n, v_new)
        return state, o

    xs = tuple(jnp.moveaxis(t, 2, 0) for t in (q_g, k_g, w, u, qk, g_last))
    _, o = lax.scan(step, jnp.zeros((b, h, d, d), jnp.float32), xs)
    return jnp.moveaxis(o, 0, 2).reshape(b, h, s, d).astype(in_dtype)


def moba_attention(q, k, v):
    b, h, s, d = q.shape
    n_blocks = -(-s // MOBA_BLOCK)
    s_pad = n_blocks * MOBA_BLOCK
    pad = ((0, 0), (0, 0), (0, s_pad - s), (0, 0))
    q, k, v = jnp.pad(q, pad), jnp.pad(k, pad), jnp.pad(v, pad)
    k_blocks = k.reshape(b, h, n_blocks, MOBA_BLOCK, d)
    v_blocks = v.reshape(b, h, n_blocks, MOBA_BLOCK, d)
    k_mean = jnp.mean(k_blocks.astype(jnp.float32), axis=3)
    k_sel = min(MOBA_TOP_K, n_blocks)
    scale = d ** -0.5
    slopes = jnp.exp2(-8.0 * jnp.arange(1, h + 1, dtype=jnp.float32) / h)
    bi = jnp.arange(b)[:, None, None, None]
    hi = jnp.arange(h)[None, :, None, None]
    blk_off = jnp.arange(MOBA_BLOCK)

    def one_query_block(i):
        start = i * MOBA_Q_BLOCK
        own = start // MOBA_BLOCK
        qc = lax.dynamic_slice_in_dim(q, start, MOBA_Q_BLOCK, axis=2)
        qpos = start + jnp.arange(MOBA_Q_BLOCK)
        gate = jnp.einsum('bhqd,bhnd->bhqn', qc.astype(jnp.float32), k_mean)
        gate = jnp.where(jnp.arange(n_blocks) < own, gate, -jnp.inf)
        gval, gidx = lax.top_k(gate, k_sel)
        sel_ok = jnp.isfinite(gval)
        k_g = k_blocks[bi, hi, gidx]
        kpos = gidx[..., None] * MOBA_BLOCK + blk_off
        dist_sel = (qpos[None, None, :, None, None] - kpos).astype(jnp.float32)
        s_sel = (jnp.einsum('bhqd,bhqjsd->bhqjs', qc, k_g).astype(jnp.float32) * scale
                 - slopes[None, :, None, None, None] * dist_sel)
        s_sel = jnp.where(sel_ok[..., None], s_sel, -jnp.inf)
        own_k = lax.dynamic_slice_in_dim(k, own * MOBA_BLOCK, MOBA_BLOCK, axis=2)
        own_v = lax.dynamic_slice_in_dim(v, own * MOBA_BLOCK, MOBA_BLOCK, axis=2)
        own_pos = own * MOBA_BLOCK + blk_off
        dist_own = (qpos[:, None] - own_pos[None, :]).astype(jnp.float32)
        s_own = (jnp.einsum('bhqd,bhsd->bhqs', qc, own_k).astype(jnp.float32) * scale
                 - slopes[:, None, None] * dist_own)
        s_own = jnp.where(own_pos[None, :] <= qpos[:, None], s_own, -jnp.inf)
        logits = jnp.concatenate([s_sel.reshape(b, h, MOBA_Q_BLOCK, k_sel * MOBA_BLOCK), s_own], axis=-1)
        p = jax.nn.softmax(logits, axis=-1)
        p_sel = p[..., :k_sel * MOBA_BLOCK].reshape(b, h, MOBA_Q_BLOCK, k_sel, MOBA_BLOCK)
        p_own = p[..., k_sel * MOBA_BLOCK:]
        v_g = v_blocks[bi, hi, gidx]
        o = jnp.einsum('bhqjs,bhqjsd->bhqd', p_sel, v_g) + jnp.einsum('bhqs,bhsd->bhqd', p_own, own_v)
        return o.astype(q.dtype)

    out = lax.map(one_query_block, jnp.arange(s_pad // MOBA_Q_BLOCK))
    out = jnp.moveaxis(out, 0, 2).reshape(b, h, s_pad, d)
    return out[:, :, :s]


def hybrid_layer(x, norm_w, w_in, conv_w, a_log, dt_bias, ret_norm_w, gdn_norm_w, q_norm_w, k_norm_w, w_out):
    h = rms_norm(x, norm_w)
    proj = jnp.einsum('btd,de->bte', h, w_in)
    sizes = (RET_W,) * 4 + (3 * GDN_W, GDN_W, GDN_HEADS, GDN_HEADS) + (MOBA_W,) * 4
    offsets = [int(o) for o in np.cumsum(sizes)[:-1]]
    rq, rk, rv, rg, gqkv, gz, ga, gb, mq, mk, mv, mz = jnp.split(proj, offsets, axis=-1)

    o_ret = retention(to_heads(rq, RET_HEADS), to_heads(rk, RET_HEADS) * HEAD_DIM ** -0.5,
                      to_heads(rv, RET_HEADS))
    y_ret = from_heads(rms_norm(o_ret, ret_norm_w[:, None, :])) * jax.nn.silu(rg)

    qkv = jax.nn.silu(causal_depthwise_conv(gqkv, conv_w))
    gq, gk, gv = jnp.split(qkv, 3, axis=-1)
    gq = l2_norm(to_heads(gq, GDN_HEADS)) * HEAD_DIM ** -0.5
    gk = l2_norm(to_heads(gk, GDN_HEADS))
    gv = to_heads(gv, GDN_HEADS)
    beta = jax.nn.sigmoid(gb.astype(jnp.float32)).transpose(0, 2, 1)
    g = (-jnp.exp(a_log.astype(jnp.float32))
         * jax.nn.softplus(ga.astype(jnp.float32) + dt_bias.astype(jnp.float32))).transpose(0, 2, 1)
    o_gdn = gated_delta_rule(gq, gk, gv, g, beta)
    y_gdn = from_heads(rms_norm(o_gdn, gdn_norm_w)) * jax.nn.silu(gz)

    mq = rms_norm(to_heads(mq, MOBA_HEADS), q_norm_w)
    mk = rms_norm(to_heads(mk, MOBA_HEADS), k_norm_w)
    o_moba = moba_attention(mq, mk, to_heads(mv, MOBA_HEADS))
    y_moba = from_heads(o_moba) * jax.nn.silu(mz)

    y = jnp.concatenate([y_ret, y_gdn, y_moba], axis=-1)
    return x + jnp.einsum('bte,ed->btd', y, w_out).astype(x.dtype)


def setup_inputs(seed: int = 0) -> dict:
    key = jax.random.key(seed)
    ks = jax.random.split(key, 12)
    f32 = jnp.float32
    x = jax.random.normal(ks[0], (BATCH, SEQ, D_MODEL), f32)
    norm_w = 1.0 + 0.02 * jax.random.normal(ks[1], (DEPTH, D_MODEL), f32)
    w_in = jax.random.normal(ks[2], (DEPTH, D_MODEL, IN_WIDTH), f32) * D_MODEL ** -0.5
    conv_w = jax.random.normal(ks[3], (DEPTH, GDN_CONV, 3 * GDN_W), f32) * GDN_CONV ** -0.5
    a_log = jnp.log(jax.random.uniform(ks[4], (DEPTH, GDN_HEADS), f32, minval=1.0, maxval=16.0))
    dt = jnp.exp(jax.random.uniform(ks[5], (DEPTH, GDN_HEADS), f32,
                                    minval=math.log(1e-3), maxval=math.log(0.1)))
    dt_bias = dt + jnp.log(-jnp.expm1(-dt))
    ret_norm_w = 1.0 + 0.02 * jax.random.normal(ks[6], (DEPTH, RET_HEADS, HEAD_DIM), f32)
    gdn_norm_w = 1.0 + 0.02 * jax.random.normal(ks[7], (DEPTH, HEAD_DIM), f32)
    q_norm_w = 1.0 + 0.02 * jax.random.normal(ks[8], (DEPTH, HEAD_DIM), f32)
    k_norm_w = 1.0 + 0.02 * jax.random.normal(ks[9], (DEPTH, HEAD_DIM), f32)
    w_out = jax.random.normal(ks[10], (DEPTH, D_MIX, D_MODEL), f32) * D_MIX ** -0.5
    return {'x': x, 'norm_w': norm_w, 'w_in': w_in, 'conv_w': conv_w, 'a_log': a_log,
            'dt_bias': dt_bias, 'ret_norm_w': ret_norm_w, 'gdn_norm_w': gdn_norm_w,
            'q_norm_w': q_norm_w, 'k_norm_w': k_norm_w, 'w_out': w_out}


def reference(x, norm_w, w_in, conv_w, a_log, dt_bias, ret_norm_w, gdn_norm_w, q_norm_w, k_norm_w, w_out):
    for layer in range(DEPTH):
        x = hybrid_layer(x, norm_w[layer], w_in[layer], conv_w[layer], a_log[layer], dt_bias[layer],
                         ret_norm_w[layer], gdn_norm_w[layer], q_norm_w[layer], k_norm_w[layer],
                         w_out[layer])
    return x
```

```cpp
#include <hip/hip_runtime.h>
#include <cstdio>
#include <cstdint>
namespace pg8 {
#define PG8_LAS __attribute__((address_space(3)))
typedef unsigned short bf16_t;
typedef short bf16x8 __attribute__((ext_vector_type(8)));
typedef float f32x4 __attribute__((ext_vector_type(4)));
typedef unsigned u32x4 __attribute__((ext_vector_type(4)));
constexpr int BM = 256, BK = 64, HALF = 128, HTB = HALF * BK * 2  , STAGE_BYTES = 8 * HTB, NXCD = 8, WGM = 8;

__host__ __device__ __forceinline__ int lds_byte(int r, int c) { const int st = (r >> 4) * 2 + (c >> 5), rr = r & 15, cc = c & 31, ob = rr * 64 + cc * 2; return st * 1024 + (ob ^ (((ob >> 9) & 1) << 5)); }
__host__ __device__ __forceinline__ void stage_rc(int b, int& R, int& C) { const int st = b / 1024, sb = b % 1024, swz = sb ^ (((sb >> 9) & 1) << 5); R = (st >> 1) * 16 + swz / 64; C = (st & 1) * 32 + (swz % 64) / 2; }
__host__ __device__ __forceinline__ int perm32(int rho) { const int n = rho >> 4, i = rho & 15; return 8 * (i >> 2) + 4 * n + (i & 3); }

struct Unit { int pm, pn; };
struct Gemm { const bf16_t* A; const bf16_t* Bt; int M, N, K; };

struct StaticOrder {
    int nM, nN, nwg, G, c;
    __host__ __device__ void init(int M, int N, int G_, int c_) { nM = M / BM; nN = N / BM; nwg = nM * nN; G = G_; c = c_; }
    __host__ __device__ bool next(int i, Unit& u) const {
        const long L = (long)i * G + c; if (L >= nwg) return false;
        int wgid = (int)L; { const int q = nwg / NXCD, r = nwg % NXCD, xcd = wgid % NXCD, off = wgid / NXCD; wgid = (xcd < r ? xcd * (q + 1) : r * (q + 1) + (xcd - r) * q) + off; }
        const int nig = WGM * nN, gid = wgid / nig, fm = gid * WGM, gsz = (nM - fm) < WGM ? (nM - fm) : WGM;
        u.pm = fm + ((wgid % nig) % gsz); u.pn = (wgid % nig) / gsz; return true;
    }
    __device__ __forceinline__ void a_ready(const Unit&) const {}
    __device__ __forceinline__ void done(const Unit&) const {}
};

__device__ __forceinline__ unsigned cvt_pk_bf16(float lo, float hi) { unsigned r; asm volatile("v_cvt_pk_bf16_f32 %0, %1, %2" : "=v"(r) : "v"(lo), "v"(hi)); return r; }
struct EpiBf16 {
    static constexpr bool PERM = true, AFTER_DRAIN = false;
    bf16_t* O; int ldc;
    __device__ __forceinline__ void operator()(const f32x4 (&acc)[2][2][4][2], const Unit& u, int wr, int wc, int fr, int fq) const {
        const int row0 = u.pm * BM + wr * 64 + fr; const int col0 = u.pn * BM + wc * 32 + 8 * fq;
#pragma unroll
        for (int ai = 0; ai < 2; ++ai)
#pragma unroll
            for (int m = 0; m < 4; ++m) { bf16_t* rowp = O + (size_t)(row0 + ai * HALF + m * 16) * ldc + col0;
#pragma unroll
                for (int bj = 0; bj < 2; ++bj) { const f32x4 v0 = acc[ai][bj][m][0], v1 = acc[ai][bj][m][1];
                    u32x4 w; w.x = cvt_pk_bf16(v0[0], v0[1]); w.y = cvt_pk_bf16(v0[2], v0[3]); w.z = cvt_pk_bf16(v1[0], v1[1]); w.w = cvt_pk_bf16(v1[2], v1[3]);
                    *(u32x4*)(rowp + bj * HALF) = w; } }
    }
};
struct EpiResF32 {
    static constexpr bool PERM = false, AFTER_DRAIN = false;
    float* C; const float* R; int ldc;
    __device__ __forceinline__ void operator()(const f32x4 (&acc)[2][2][4][2], const Unit& u, int wr, int wc, int fr, int fq) const {
        const int row0 = u.pm * BM + wr * 64 + fr, col0 = u.pn * BM + wc * 32 + 4 * fq;
#pragma unroll
        for (int ai = 0; ai < 2; ++ai)
#pragma unroll
            for (int m = 0; m < 4; ++m) { const size_t off = (size_t)(row0 + ai * HALF + m * 16) * ldc + col0;
#pragma unroll
                for (int bj = 0; bj < 2; ++bj)
#pragma unroll
                    for (int n = 0; n < 2; ++n) { const size_t i = off + bj * HALF + n * 16; const f32x4 r = *(const f32x4*)(R + i); *(f32x4*)(C + i) = r + acc[ai][bj][m][n]; } }
    }
};
template <class Epi, class Sched, bool ALIGN_EPI = false, bool SP2 = false>
__device__ __forceinline__ void gemm_phase(PG8_LAS unsigned char* lds, const Gemm g, const Sched& S, const Epi& E, const int tid) {
    const int  wid = __builtin_amdgcn_readfirstlane(tid >> 6), lane = tid & 63, wr = wid >> 2, wc = wid & 3, fr = lane & 15, fq = lane >> 4;
    const int K = g.K, nt = K / BK;
    unsigned voffA[2], voffB[2];
#pragma unroll
    for (int i = 0; i < 2; ++i) { int R, C; stage_rc(tid * 16 + i * 8192, R, C); const int Rb = Epi::PERM ? ((R & ~31) + perm32(R & 31)) : R;
        voffA[i] = (unsigned)(R * K + C) * 2u; voffB[i] = (unsigned)(Rb * K + C) * 2u; }
    const size_t kstep = (size_t)(BK * 2);
    const size_t hstep = (size_t)HALF * K * 2;
    const size_t tstep = 2 * hstep;
    const unsigned ldsw = (unsigned)wid * 1024u;
    const int aoff = lds_byte(wr * 64 + fr, fq * 8), boff = lds_byte(wc * 32 + fr, fq * 8);
#define PG8_SA(b, h) (((b) * 2 + (h)) * HTB)
#define PG8_SB(b, h) ((4 + (b) * 2 + (h)) * HTB)
#define PG8_STAGE(bufoff, gbase, voff) do { _Pragma("unroll") for (int _i = 0; _i < 2; ++_i) \
        __builtin_amdgcn_global_load_lds((const unsigned*)((const char*)(gbase) + (voff)[_i]), (PG8_LAS unsigned*)(lds + (bufoff) + ldsw + _i * 8192), 16, 0, 0); } while (0)
#define PG8_LDA(dst, b, h) do { _Pragma("unroll") for (int m = 0; m < 4; ++m) _Pragma("unroll") for (int k = 0; k < 2; ++k) dst[m][k] = *(const PG8_LAS bf16x8*)(lds + PG8_SA(b, h) + aoff + m * 2048 + k * 1024); } while (0)
#define PG8_LDB(dst, b, h) do { _Pragma("unroll") for (int n = 0; n < 2; ++n) _Pragma("unroll") for (int k = 0; k < 2; ++k) dst[n][k] = *(const PG8_LAS bf16x8*)(lds + PG8_SB(b, h) + boff + n * 2048 + k * 1024); } while (0)
#define PG8_MMA(ai, bj, At, Bt) do { __builtin_amdgcn_s_setprio(1); _Pragma("unroll") for (int m = 0; m < 4; ++m) _Pragma("unroll") for (int n = 0; n < 2; ++n) _Pragma("unroll") for (int k = 0; k < 2; ++k) \
        acc[ai][bj][m][n] = __builtin_amdgcn_mfma_f32_16x16x32_bf16(Bt[n][k], At[m][k], acc[ai][bj][m][n], 0, 0, 0); __builtin_amdgcn_s_setprio(0); } while (0)
#define PG8_WAIT_V(n) asm volatile("s_waitcnt vmcnt(" #n ")" ::: "memory")
#define PG8_WAIT_L(n) asm volatile("s_waitcnt lgkmcnt(" #n ")" ::: "memory")
#define PG8_BAR __builtin_amdgcn_s_barrier()
#define PG8_SCHED __builtin_amdgcn_sched_barrier(0)
    Unit cur, nxt; int ui = 0;
    if (!S.next(0, cur)) return;
    f32x4 acc[2][2][4][2];
#pragma unroll
    for (int a = 0; a < 2; ++a)
#pragma unroll
        for (int b = 0; b < 2; ++b)
#pragma unroll
            for (int m = 0; m < 4; ++m)
#pragma unroll
                for (int n = 0; n < 2; ++n) acc[a][b][m][n] = (f32x4){0.f, 0.f, 0.f, 0.f};
    bf16x8 At[4][2], B0[2][2], B1[2][2];
    const char* cA = (const char*)g.A + (size_t)cur.pm * tstep; const char* cB = (const char*)g.Bt + (size_t)cur.pn * tstep;
    S.a_ready(cur);
    if constexpr (SP2) {
        PG8_STAGE(PG8_SB(0, 0), cB, voffB); PG8_STAGE(PG8_SB(0, 1), cB + hstep, voffB); PG8_STAGE(PG8_SA(0, 0), cA, voffA); PG8_STAGE(PG8_SA(0, 1), cA + hstep, voffA);
        if (wr == 1) PG8_BAR;
        PG8_WAIT_V(2); PG8_BAR;
        PG8_STAGE(PG8_SB(1, 0), cB + kstep, voffB); PG8_STAGE(PG8_SA(1, 0), cA + kstep, voffA); PG8_STAGE(PG8_SB(1, 1), cB + hstep + kstep, voffB);
        PG8_WAIT_V(6); PG8_BAR;
    } else {
        PG8_STAGE(PG8_SB(0, 0), cB, voffB); PG8_STAGE(PG8_SA(0, 0), cA, voffA); PG8_STAGE(PG8_SB(0, 1), cB + hstep, voffB); PG8_STAGE(PG8_SA(0, 1), cA + hstep, voffA);
        if (wr == 1) PG8_BAR;
        PG8_WAIT_V(4); PG8_BAR;
        PG8_STAGE(PG8_SB(1, 0), cB + kstep, voffB); PG8_STAGE(PG8_SA(1, 0), cA + kstep, voffA); PG8_STAGE(PG8_SB(1, 1), cB + hstep + kstep, voffB);
        PG8_WAIT_V(6); PG8_BAR;
    }
    for (;;) {
        const bool has_next = S.next(ui + 1, nxt);
        const char* nA = has_next ? (const char*)g.A + (size_t)nxt.pm * tstep : cA; const char* nB = has_next ? (const char*)g.Bt + (size_t)nxt.pn * tstep : cB;
        for (int t = 0; t < nt; t += 2) {
            const bool last = (t == nt - 2);
            const char* a1 = cA + (size_t)(t + 1) * kstep;
            const char* a2 = last ? nA : cA + (size_t)(t + 2) * kstep; const char* b2 = last ? nB : cB + (size_t)(t + 2) * kstep;
            const char* a3 = a2 + kstep; const char* b3 = b2 + kstep;
            if (last && has_next) S.a_ready(nxt);
            if constexpr (SP2) {
            PG8_LDB(B0, 0, 0); PG8_LDB(B1, 0, 1); PG8_SCHED; PG8_LDA(At, 0, 0); PG8_STAGE(PG8_SA(1, 1), a1 + hstep, voffA);
            PG8_WAIT_V(8); PG8_WAIT_L(0); PG8_BAR; PG8_MMA(0, 0, At, B0); PG8_MMA(0, 1, At, B1); PG8_BAR; PG8_SCHED;
            PG8_LDA(At, 0, 1); PG8_STAGE(PG8_SB(0, 0), b2, voffB); PG8_STAGE(PG8_SB(0, 1), b2 + hstep, voffB); PG8_STAGE(PG8_SA(0, 0), a2, voffA);
            PG8_WAIT_V(8); PG8_WAIT_L(0); PG8_BAR; PG8_MMA(1, 0, At, B0); PG8_MMA(1, 1, At, B1); PG8_BAR; PG8_SCHED;
            PG8_LDB(B0, 1, 0); PG8_LDB(B1, 1, 1); PG8_SCHED; PG8_LDA(At, 1, 0); PG8_STAGE(PG8_SA(0, 1), a2 + hstep, voffA);
            PG8_WAIT_V(8); PG8_WAIT_L(0); PG8_BAR; PG8_MMA(0, 0, At, B0); PG8_MMA(0, 1, At, B1); PG8_BAR; PG8_SCHED;
            PG8_LDA(At, 1, 1); PG8_STAGE(PG8_SB(1, 0), b3, voffB); PG8_STAGE(PG8_SB(1, 1), b3 + hstep, voffB); PG8_STAGE(PG8_SA(1, 0), a3, voffA);
            PG8_WAIT_V(8); PG8_WAIT_L(0); PG8_BAR; PG8_MMA(1, 0, At, B0); PG8_MMA(1, 1, At, B1); PG8_BAR; PG8_SCHED;
            } else {
            PG8_LDB(B0, 0, 0); PG8_SCHED; PG8_LDA(At, 0, 0); PG8_STAGE(PG8_SA(1, 1), a1 + hstep, voffA);
            PG8_WAIT_L(8); PG8_BAR; PG8_WAIT_L(0); PG8_MMA(0, 0, At, B0); PG8_BAR; PG8_SCHED;
            PG8_LDB(B1, 0, 1); PG8_STAGE(PG8_SB(0, 0), b2, voffB);
            PG8_BAR; PG8_WAIT_L(0); PG8_MMA(0, 1, At, B1); PG8_BAR;
            PG8_LDA(At, 0, 1); PG8_STAGE(PG8_SA(0, 0), a2, voffA);
            PG8_BAR; PG8_WAIT_L(0); PG8_MMA(1, 0, At, B0); PG8_BAR; PG8_SCHED;
            PG8_STAGE(PG8_SB(0, 1), b2 + hstep, voffB);
            PG8_WAIT_V(6); PG8_BAR; PG8_MMA(1, 1, At, B1); PG8_BAR;
            PG8_LDB(B0, 1, 0); PG8_SCHED; PG8_LDA(At, 1, 0); PG8_STAGE(PG8_SA(0, 1), a2 + hstep, voffA);
            PG8_WAIT_L(8); PG8_BAR; PG8_WAIT_L(0); PG8_MMA(0, 0, At, B0); PG8_BAR; PG8_SCHED;
            PG8_LDB(B1, 1, 1); PG8_STAGE(PG8_SB(1, 0), b3, voffB);
            PG8_BAR; PG8_WAIT_L(0); PG8_MMA(0, 1, At, B1); PG8_BAR;
            PG8_LDA(At, 1, 1); PG8_STAGE(PG8_SA(1, 0), a3, voffA);
            PG8_BAR; PG8_WAIT_L(0); PG8_MMA(1, 0, At, B0); PG8_BAR; PG8_SCHED;
            PG8_STAGE(PG8_SB(1, 1), b3 + hstep, voffB);
            PG8_WAIT_V(6); PG8_BAR; PG8_MMA(1, 1, At, B1); PG8_BAR;
            }
        }
        if constexpr (ALIGN_EPI) { if (wr == 0) PG8_BAR; }
        if constexpr (!Epi::AFTER_DRAIN) { E(acc, cur, wr, wc, fr, fq); S.done(cur); }
        if (!has_next) break;
#pragma unroll
        for (int a = 0; a < 2; ++a)
#pragma unroll
            for (int b = 0; b < 2; ++b)
#pragma unroll
                for (int m = 0; m < 4; ++m)
#pragma unroll
                    for (int n = 0; n < 2; ++n) acc[a][b][m][n] = (f32x4){0.f, 0.f, 0.f, 0.f};
        cur = nxt; cA = nA; cB = nB; ++ui;
        if constexpr (ALIGN_EPI) { if (wr == 1) PG8_BAR; }
    }
    PG8_WAIT_V(0);
    if constexpr (!ALIGN_EPI) { if (wr == 0) PG8_BAR; }
    PG8_BAR;
    if constexpr (Epi::AFTER_DRAIN) { E.fused(acc, cur, wr, wc, fr, fq, lds, wid, lane); S.done(cur); }
#undef PG8_SA
#undef PG8_SB
#undef PG8_STAGE
#undef PG8_LDA
#undef PG8_LDB
#undef PG8_MMA
#undef PG8_WAIT_V
#undef PG8_WAIT_L
#undef PG8_BAR
#undef PG8_SCHED
}
}
#define GAS __attribute__((address_space(1)))
#define LAS __attribute__((address_space(3)))
typedef unsigned short bf16;
typedef unsigned v4u __attribute__((ext_vector_type(4)));
typedef float f32x4 __attribute__((ext_vector_type(4)));
typedef short bf16x8 __attribute__((ext_vector_type(8)));
typedef GAS unsigned gu32;
typedef GAS unsigned long long gu64;
#define RLX_AGENT __ATOMIC_RELAXED, __HIP_MEMORY_SCOPE_AGENT
#define LDS_WAIT() asm volatile("s_waitcnt lgkmcnt(0)" ::: "memory")
#define VM_WAIT() asm volatile("s_waitcnt vmcnt(0)" ::: "memory")
__device__ __forceinline__ unsigned long long rt() { return __builtin_amdgcn_s_memrealtime(); }
__device__ __forceinline__ unsigned f2bf(float f) { unsigned u = __builtin_bit_cast(unsigned, f); return (u + 0x7fffu + ((u >> 16) & 1u)) >> 16; }
__device__ __forceinline__ unsigned pk2(float lo, float hi) { return f2bf(lo) | (f2bf(hi) << 16); }

#define XB_TMO      128
#define XB_XCNT(j)  (256  + 64 * (j))
#define XB_XSUB(j)  (1280 + 64 * (j))
#define XB_XGEN(j)  (2304 + 64 * (j))
#define XB_TOP      3328
#define XB_TOPGEN   3392
#define XCD_BAR_WORDS 3456
#define XB_SPIN_CAP (1u << 18)

__device__ __forceinline__ unsigned xb_ld(unsigned* p)              { return __hip_atomic_load(p, __ATOMIC_RELAXED, __HIP_MEMORY_SCOPE_AGENT); }
__device__ __forceinline__ unsigned xb_add(unsigned* p, unsigned v) { return __hip_atomic_fetch_add(p, v, __ATOMIC_RELAXED, __HIP_MEMORY_SCOPE_AGENT); }
__device__ __forceinline__ unsigned xb_xcc_id() { return (unsigned)__builtin_amdgcn_s_getreg((3 << 11) | 20) & 0xFu; }
#define XB_SPIN(cond, bar) do { unsigned _sp = 0; while (cond) { __builtin_amdgcn_s_sleep(1); \
    if ((++_sp & 255u) == 0u) { if (xb_ld(&(bar)[XB_TMO])) break; if (_sp > XB_SPIN_CAP) { atomicAdd(&(bar)[XB_TMO], 1u); break; } } } } while (0)

struct XcdBarrier {
    unsigned* bar; unsigned x;
    volatile LAS unsigned* st;
};

__device__ __forceinline__ XcdBarrier xcd_barrier_post(unsigned* bar, volatile LAS unsigned* st) {
    XcdBarrier b; b.bar = bar; b.x = xb_xcc_id(); b.st = st;
    if (threadIdx.x == 0) (void)xb_add(&bar[XB_XCNT(b.x)], 1u);
    return b;
}
__device__ __forceinline__ void xcd_barrier_complete(unsigned* bar, unsigned x, unsigned& nloc, unsigned& nx) {
    const unsigned G = gridDim.x * gridDim.y * gridDim.z;
    unsigned sum, cnt, mine, sp = 0u;
    for (;;) {
        sum = 0u; cnt = 0u; mine = 0u;
#pragma unroll
        for (unsigned j = 0; j < 16; ++j) { const unsigned c = xb_ld(&bar[XB_XCNT(j)]); sum += c; cnt += (c > 0u) ? 1u : 0u; mine = (j == x) ? c : mine; }
        if (sum == G) break;
        __builtin_amdgcn_s_sleep(1);
        if ((++sp & 255u) == 0u) { if (xb_ld(&bar[XB_TMO])) break; if (sp > XB_SPIN_CAP) { atomicAdd(&bar[XB_TMO], 1u); break; } }
    }
    nloc = mine > 0u ? mine : 1u; nx = cnt > 0u ? cnt : 1u;
}

__device__ __forceinline__ void xcd_barrier(const XcdBarrier& b) {
    asm volatile("s_waitcnt vmcnt(0)" ::: "memory");
    __syncthreads();
    if (threadIdx.x == 0) {
        unsigned* bar = b.bar;
        __builtin_amdgcn_s_waitcnt(0);
        unsigned nloc = b.st[0], nx = b.st[1];
        if (nloc == 0u) { xcd_barrier_complete(bar, b.x, nloc, nx); b.st[0] = nloc; b.st[1] = nx; }
        const unsigned old = xb_add(&bar[XB_XSUB(b.x)], 1u);
        const unsigned gen = old / nloc;
        if (old + 1u == (gen + 1u) * nloc) {
            __builtin_amdgcn_fence(__ATOMIC_RELEASE, "agent");
            asm volatile("s_waitcnt vmcnt(0)" ::: "memory");
            const unsigned og = xb_add(&bar[XB_TOP], 1u);
            const unsigned tg = og / nx;
            if (og + 1u == (tg + 1u) * nx) xb_add(&bar[XB_TOPGEN], 1u);
            else XB_SPIN(xb_ld(&bar[XB_TOPGEN]) == tg, bar);
            __builtin_amdgcn_fence(__ATOMIC_ACQUIRE, "agent");
            xb_add(&bar[XB_XGEN(b.x)], 1u);
            asm volatile("s_waitcnt vmcnt(0)" ::: "memory");
        } else {
            XB_SPIN(xb_ld(&bar[XB_XGEN(b.x)]) == gen, bar);
            __builtin_amdgcn_fence(__ATOMIC_ACQUIRE, "agent");
            asm volatile("s_waitcnt vmcnt(0)" ::: "memory");
        }
    }
    __syncthreads();
}

constexpr int NWAVES = 8, NTHREADS = NWAVES * 64;
constexpr int BATCH = 2, T = 8192, DM = 2048, M = BATCH * T, HD = 128, RH = 4, GH = 6, MH = 6, NP = 8192, INW = 8204, DEPTH = 2;
constexpr int C_RQ = 0, C_RK = 512, C_RV = 1024, C_RG = 1536, C_GQ = 2048, C_GK = 2816, C_GV = 3584, C_GZ = 4352, C_MQ = 5120, C_MK = 5888, C_MV = 6656, C_MZ = 7424;
constexpr int NSH = 10;
constexpr float RMS_EPS = 1e-6f;
constexpr int MOBA_BLK = 256, MOBA_NB = T / MOBA_BLK;

constexpr size_t MiB = 1u << 20;
constexpr size_t WS_CTL = 0, CTL_ZERO_BYTES = 1 * MiB;
constexpr size_t WS_WIN = 2 * MiB;
constexpr size_t WS_WOUT = 66 * MiB;
constexpr size_t WS_H = 82 * MiB;
constexpr size_t WS_Y = 82 * MiB;
constexpr size_t WS_GAB = 146 * MiB;
constexpr size_t WS_KMEAN = 147 * MiB;
constexpr size_t WS_PROJ = 148 * MiB;
constexpr size_t WS_GP = 404 * MiB;
constexpr size_t WS_END = 478 * MiB;
constexpr int CW_TMO = 0, CW_CODE = 1, CW_BAR = 4096;

constexpr int RING_OFF = 0, RING_BYTES = 131072;
constexpr int LDSCTL_OFF = RING_BYTES, MISC_OFF = LDSCTL_OFF + 320;
constexpr int LDS_BYTES = 147456;

__device__ __forceinline__ float wave_sum(float v) {
#pragma unroll
    for (int o = 1; o < 64; o <<= 1) v += __shfl_xor(v, o);
    return v;
}
__device__ __forceinline__ float wave_max(float v) {
#pragma unroll
    for (int o = 1; o < 64; o <<= 1) v = fmaxf(v, __shfl_xor(v, o));
    return v;
}
__device__ __forceinline__ float bf2f(unsigned short u) { return __builtin_bit_cast(float, (unsigned)u << 16); }
__device__ __forceinline__ float bflo(unsigned u) { return __builtin_bit_cast(float, u << 16); }
__device__ __forceinline__ float bfhi(unsigned u) { return __builtin_bit_cast(float, u & 0xffff0000u); }
__device__ __forceinline__ float silu_f(float x) { return x / (1.f + expf(-x)); }

struct Args { const float* in[11]; float* out; unsigned char* ws; int ph_lo, ph_hi; };

__device__ __forceinline__ void p0_transpose_item(const float* W, int ldw, int srccol0, int K, bf16* WT, int dstrow0, LAS float* scr, int k0, int lane) {
#pragma unroll 8
    for (int i = 0; i < 32; ++i) { const int kk = 2 * i + (lane >> 5); scr[kk * 33 + (lane & 31)] = W[(size_t)(k0 + kk) * ldw + srccol0 + (lane & 31)]; }
    LDS_WAIT(); asm volatile("" ::: "memory");
    const int c = lane & 7;
#pragma unroll
    for (int j = 0; j < 4; ++j) { const int n = (lane >> 3) + 8 * j; const LAS float* s = scr + (8 * c) * 33 + n;
        v4u o; o.x = pk2(s[0 * 33], s[1 * 33]); o.y = pk2(s[2 * 33], s[3 * 33]); o.z = pk2(s[4 * 33], s[5 * 33]); o.w = pk2(s[6 * 33], s[7 * 33]);
        *(GAS v4u*)(WT + (size_t)(dstrow0 + n) * K + k0 + 8 * c) = o; }
    LDS_WAIT(); asm volatile("" ::: "memory");
}
__device__ __forceinline__ void p0_weights(const Args& a, LAS unsigned char* lds, int gw, int NGW, int wave, int lane) {
    LAS float* scr = (LAS float*)(lds + RING_OFF + wave * 16384);
    constexpr int I_IN = (DM / 64) * (NP / 32), I_OUT = (DM / 64) * (DM / 32);
    constexpr int NITEMS = DEPTH * (I_IN + I_OUT);
    for (int it = gw; it < NITEMS; it += NGW) {
        int r = it; const int l = r / (I_IN + I_OUT); r -= l * (I_IN + I_OUT);
        if (r < I_IN) { const int kb = r / (NP / 32), nb = r % (NP / 32), n0 = 32 * nb; const int src = n0 + (n0 >= 5120 ? 12 : 0);
            p0_transpose_item(a.in[2] + (size_t)l * DM * INW, INW, src, DM, (bf16*)(a.ws + WS_WIN) + (size_t)l * NP * DM, n0, scr, 64 * kb, lane); }
        else { r -= I_IN; const int kb = r / (DM / 32), nb = r % (DM / 32), n0 = 32 * nb;
            p0_transpose_item(a.in[10] + (size_t)l * DM * DM, DM, n0, DM, (bf16*)(a.ws + WS_WOUT) + (size_t)l * DM * DM, n0, scr, 64 * kb, lane); }
    }
}
__device__ __forceinline__ void p0_rows(const Args& a, int l, const float* xin, LAS unsigned char* lds, int gw, int NGW, int tid, int lane) {
    LAS float* wab = (LAS float*)(lds + RING_OFF);
    const float* win = a.in[2] + (size_t)l * DM * INW;
    __syncthreads();
    for (int idx = tid; idx < DM * 12; idx += NTHREADS) { const int k = idx / 12, c = idx - 12 * k; wab[c * DM + k] = win[(size_t)k * INW + 5120 + c]; }
    __syncthreads();
    const float* nw = a.in[1] + (size_t)l * DM;
    bf16* H = (bf16*)(a.ws + WS_H); float* GAB = (float*)(a.ws + WS_GAB);
    for (int m = gw; m < M; m += NGW) {
        const f32x4* xr = (const f32x4*)(xin + (size_t)m * DM) + lane;
        f32x4 v[8]; float ss = 0.f;
#pragma unroll
        for (int j = 0; j < 8; ++j) { v[j] = xr[64 * j]; ss += (v[j].x * v[j].x + v[j].y * v[j].y) + (v[j].z * v[j].z + v[j].w * v[j].w); }
        ss = wave_sum(ss);
        const float r = 1.0f / sqrtf(ss * (1.f / DM) + RMS_EPS);
        unsigned long long* o8 = (unsigned long long*)(H + (size_t)m * DM) + lane;
#pragma unroll
        for (int j = 0; j < 8; ++j) {
            const f32x4 w = ((const f32x4*)nw)[lane + 64 * j];
            v[j] = v[j] * r * w;
            o8[64 * j] = (unsigned long long)pk2(v[j].x, v[j].y) | ((unsigned long long)pk2(v[j].z, v[j].w) << 32);
        }
        float val = 0.f;
#pragma unroll 1
        for (int c = 0; c < 12; ++c) {
            float s = 0.f;
#pragma unroll
            for (int j = 0; j < 8; ++j) { const f32x4 wv = *(const LAS f32x4*)(wab + c * DM + 4 * lane + 256 * j); s += (v[j].x * wv.x + v[j].y * wv.y) + (v[j].z * wv.z + v[j].w * wv.w); }
            s = wave_sum(s); val = (lane == c) ? s : val;
        }
        if (lane < 12) {
            float o;
            if (lane < 6) { const float al = a.in[4][l * GH + lane], db = a.in[5][l * GH + lane]; const float z = val + db;
                const float sp = (z > 20.f) ? z : log1pf(expf(z)); o = -expf(al) * sp; }
            else o = 1.f / (1.f + expf(-val));
            GAB[(size_t)m * 12 + lane] = o;
        }
    }
    __syncthreads();
}

__device__ __forceinline__ void p2_prep(const Args& a, int l, int gw, int NGW, int lane) {
    bf16* P = (bf16*)(a.ws + WS_PROJ); bf16* GP = (bf16*)(a.ws + WS_GP);
    const float* convw = a.in[3] + (size_t)l * 4 * 2304;
    const float* qnw = a.in[8] + l * HD; const float* knw = a.in[9] + l * HD;
    const int d0 = 2 * lane;
    for (int m = gw; m < M; m += NGW) {
        const int b = m / T, t = m - b * T;
        bf16* prow = P + (size_t)m * NP;
        for (int h = 0; h < GH; ++h) {
            float o[3][2];
#pragma unroll
            for (int part = 0; part < 3; ++part) {
                const int c = part * 768 + h * HD + d0;
                float s0 = 0.f, s1 = 0.f;
#pragma unroll
                for (int j = 0; j < 4; ++j) { const int tt = t - 3 + j;
                    if (tt >= 0) { const unsigned u = *(const unsigned*)(prow + (long)(j - 3) * NP + C_GQ + c); const float2 w = *(const float2*)(convw + j * 2304 + c); s0 += w.x * bflo(u); s1 += w.y * bfhi(u); } }
                o[part][0] = silu_f(s0); o[part][1] = silu_f(s1);
            }
            const float qs = wave_sum(o[0][0] * o[0][0] + o[0][1] * o[0][1]), ks = wave_sum(o[1][0] * o[1][0] + o[1][1] * o[1][1]);
            const float qr = (1.0f / sqrtf(qs + RMS_EPS)) * 0.08838834764831845f, kr = 1.0f / sqrtf(ks + RMS_EPS);
            bf16* g = GP + (size_t)m * 2304 + h * HD + d0;
            *(unsigned*)(g) = pk2(o[0][0] * qr, o[0][1] * qr);
            *(unsigned*)(g + 768) = pk2(o[1][0] * kr, o[1][1] * kr);
            *(unsigned*)(g + 1536) = pk2(o[2][0], o[2][1]);
        }
        for (int h = 0; h < MH; ++h) {
            const unsigned q = *(const unsigned*)(prow + C_MQ + h * HD + d0), k = *(const unsigned*)(prow + C_MK + h * HD + d0);
            const float q0 = bflo(q), q1 = bfhi(q), k0 = bflo(k), k1 = bfhi(k);
            const float qs = wave_sum(q0 * q0 + q1 * q1), ks = wave_sum(k0 * k0 + k1 * k1);
            const float qr = 1.0f / sqrtf(qs * (1.f / HD) + RMS_EPS), kr = 1.0f / sqrtf(ks * (1.f / HD) + RMS_EPS);
            const float2 qw = *(const float2*)(qnw + d0), kw = *(const float2*)(knw + d0);
            *(unsigned*)(prow + C_MQ + h * HD + d0) = pk2(q0 * qr * qw.x, q1 * qr * qw.y);
            *(unsigned*)(prow + C_MK + h * HD + d0) = pk2(k0 * kr * kw.x, k1 * kr * kw.y);
        }
    }
}
__device__ __forceinline__ void p2_kmean(const Args& a, int gw, int NGW, int lane) {
    const bf16* P = (const bf16*)(a.ws + WS_PROJ); float* KM = (float*)(a.ws + WS_KMEAN);
    for (int it = gw; it < BATCH * MH * MOBA_NB; it += NGW) {
        const int bh = it / MOBA_NB, blk = it - bh * MOBA_NB, b = bh / MH, h = bh - b * MH;
        const bf16* base = P + ((size_t)b * T + (size_t)blk * MOBA_BLK) * NP + C_MK + h * HD + 2 * lane;
        float s0 = 0.f, s1 = 0.f;
        for (int r = 0; r < MOBA_BLK; ++r) { const unsigned u = *(const unsigned*)(base + (size_t)r * NP); s0 += bflo(u); s1 += bfhi(u); }
        *(float2*)(KM + (size_t)it * HD + 2 * lane) = make_float2(s0 * (1.f / MOBA_BLK), s1 * (1.f / MOBA_BLK));
    }
}
__device__ __forceinline__ void p2_scan_item(const Args& a, int item, int lane) {
    bf16* P = (bf16*)(a.ws + WS_PROJ); bf16* GP = (bf16*)(a.ws + WS_GP); const float* GAB = (const float*)(a.ws + WS_GAB);
    const int sh = item >> 2, b = sh / NSH, hh = sh - b * NSH, e = (item & 3) * 32 + (lane & 31), dh = lane >> 5;
    const bool delta = hh >= RH; const int h = delta ? hh - RH : hh;
    bf16* qb = delta ? GP + h * HD : P + C_RQ + h * HD; bf16* kb = delta ? GP + 768 + h * HD : P + C_RK + h * HD; bf16* vb = delta ? GP + 1536 + h * HD : P + C_RV + h * HD;
    const size_t ld = delta ? 2304 : NP;
    const float kscale = delta ? 1.0f : 0.08838834764831845f, gam = 1.0f - exp2f(-5.0f - (float)h);
    float S[64];
#pragma unroll
    for (int d = 0; d < 64; ++d) S[d] = 0.f;
    for (int t = 0; t < T; ++t) {
        size_t row = (size_t)b * T + t;
        asm volatile("" : "+v"(row));
        const v4u* kp = (const v4u*)(kb + row * ld + 64 * dh); const v4u* qp = (const v4u*)(qb + row * ld + 64 * dh);
        float at = gam, bt = 1.0f;
        if (delta) { at = expf(GAB[row * 12 + h]); bt = GAB[row * 12 + 6 + h]; }
        const float vt = bf2f(vb[row * ld + e]);
        float kf[64];
#pragma unroll
        for (int i = 0; i < 8; ++i) { const v4u u = kp[i];
            kf[8 * i] = bflo(u.x) * kscale; kf[8 * i + 1] = bfhi(u.x) * kscale; kf[8 * i + 2] = bflo(u.y) * kscale; kf[8 * i + 3] = bfhi(u.y) * kscale;
            kf[8 * i + 4] = bflo(u.z) * kscale; kf[8 * i + 5] = bfhi(u.z) * kscale; kf[8 * i + 6] = bflo(u.w) * kscale; kf[8 * i + 7] = bfhi(u.w) * kscale; }
        float kS = 0.f;
        if (delta) {
#pragma unroll
            for (int d = 0; d < 64; ++d) kS += kf[d] * S[d];
            kS += __shfl_xor(kS, 32);
        }
        const float r = bt * (vt - at * kS);
#pragma unroll
        for (int d = 0; d < 64; ++d) S[d] = at * S[d] + kf[d] * r;
        float o = 0.f;
#pragma unroll
        for (int i = 0; i < 8; ++i) { const v4u u = qp[i];
            o += bflo(u.x) * S[8 * i] + bfhi(u.x) * S[8 * i + 1]; o += bflo(u.y) * S[8 * i + 2] + bfhi(u.y) * S[8 * i + 3];
            o += bflo(u.z) * S[8 * i + 4] + bfhi(u.z) * S[8 * i + 5]; o += bflo(u.w) * S[8 * i + 6] + bfhi(u.w) * S[8 * i + 7]; }
        o += __shfl_xor(o, 32);
        if (dh == 0) vb[row * ld + e] = (bf16)f2bf(o);
    }
}
__device__ __forceinline__ void p2_moba_query(const Args& a, int l, int qi, LAS float* pbuf, int lane) {
    const float* KM = (const float*)(a.ws + WS_KMEAN);
    const bf16* P = (const bf16*)(a.ws + WS_PROJ); bf16* Y = (bf16*)(a.ws + WS_Y);
    const int bh = qi / T, t = qi - bh * T, b = bh / MH, h = bh - b * MH, own = t >> 8;
    const float NEG = -__builtin_inff();
    const size_t m = (size_t)b * T + t;
    float q[HD];
    { size_t mo = m; asm volatile("" : "+v"(mo));
      const v4u* qp = (const v4u*)(P + mo * NP + C_MQ + h * HD);
#pragma unroll
      for (int i = 0; i < 16; ++i) { const v4u u = qp[i]; q[8 * i] = bflo(u.x); q[8 * i + 1] = bfhi(u.x); q[8 * i + 2] = bflo(u.y); q[8 * i + 3] = bfhi(u.y); q[8 * i + 4] = bflo(u.z); q[8 * i + 5] = bfhi(u.z); q[8 * i + 6] = bflo(u.w); q[8 * i + 7] = bfhi(u.w); } }
    float gate = NEG;
    if (lane < own) { const f32x4* km = (const f32x4*)(KM + ((size_t)bh * MOBA_NB + lane) * HD); float s = 0.f;
#pragma unroll
        for (int d4 = 0; d4 < HD / 4; ++d4) { const f32x4 k = km[d4]; s += (q[4 * d4] * k.x + q[4 * d4 + 1] * k.y) + (q[4 * d4 + 2] * k.z + q[4 * d4 + 3] * k.w); }
        gate = s; }
    int sel[3]; bool ok[3];
#pragma unroll
    for (int r = 0; r < 3; ++r) {
        float best = gate; int bi = lane;
#pragma unroll
        for (int o = 32; o >= 1; o >>= 1) { const float ov = __shfl_xor(best, o); const int oi = __shfl_xor(bi, o); if (ov > best || (ov == best && oi < bi)) { best = ov; bi = oi; } }
        sel[r] = bi; ok[r] = best > NEG; if (lane == bi) gate = NEG;
    }
    const float scale = 0.08838834764831845f, slope = exp2f(-8.0f * (float)(h + 1) / (float)MH);
    float lg[16];
#pragma unroll
    for (int g = 0; g < 4; ++g) {
        const int blk = (g < 3) ? sel[g < 3 ? g : 0] : own; const bool vg = (g < 3) ? ok[g < 3 ? g : 0] : true;
#pragma unroll
        for (int r = 0; r < 4; ++r) {
            float s = NEG;
            if (vg) {
                const int kpos = blk * MOBA_BLK + r * 64 + lane;
                const v4u* kp = (const v4u*)(P + ((size_t)b * T + kpos) * NP + C_MK + h * HD); float dsum = 0.f;
#pragma unroll
                for (int i = 0; i < 16; ++i) { const v4u u = kp[i];
                    dsum += (q[8 * i] * bflo(u.x) + q[8 * i + 1] * bfhi(u.x)) + (q[8 * i + 2] * bflo(u.y) + q[8 * i + 3] * bfhi(u.y));
                    dsum += (q[8 * i + 4] * bflo(u.z) + q[8 * i + 5] * bfhi(u.z)) + (q[8 * i + 6] * bflo(u.w) + q[8 * i + 7] * bfhi(u.w)); }
                const float sv = dsum * scale - slope * (float)(t - kpos);
                s = (g < 3 || kpos <= t) ? sv : NEG;
            }
            lg[g * 4 + r] = s;
        }
    }
    float mx = lg[0];
#pragma unroll
    for (int i = 1; i < 16; ++i) mx = fmaxf(mx, lg[i]);
    mx = wave_max(mx);
    float sum = 0.f;
#pragma unroll
    for (int i = 0; i < 16; ++i) { lg[i] = expf(lg[i] - mx); sum += lg[i]; }
    sum = wave_sum(sum);
    const float inv = 1.0f / sum;
#pragma unroll
    for (int i = 0; i < 16; ++i) pbuf[i * 64 + lane] = lg[i] * inv;
    LDS_WAIT(); asm volatile("" ::: "memory");
    float o0 = 0.f, o1 = 0.f;
#pragma unroll
    for (int g = 0; g < 4; ++g) {
        const int blk = (g < 3) ? sel[g < 3 ? g : 0] : own; const bool vg = (g < 3) ? ok[g < 3 ? g : 0] : true;
        if (vg) {
            const int nk = (g < 3) ? MOBA_BLK : (t - own * MOBA_BLK + 1);
            const bf16* vb = P + ((size_t)(b * T + blk * MOBA_BLK)) * NP + C_MV + h * HD + 2 * lane;
            for (int i = 0; i < nk; ++i) { const float pj = pbuf[g * 256 + i]; const unsigned u = *(const unsigned*)(vb + (size_t)i * NP); o0 += pj * bflo(u); o1 += pj * bfhi(u); }
        }
    }
    const unsigned zu = *(const unsigned*)(P + m * NP + C_MZ + h * HD + 2 * lane);
    *(unsigned*)(Y + m * DM + 1280 + h * HD + 2 * lane) = pk2(o0 * silu_f(bflo(zu)), o1 * silu_f(bfhi(zu)));
    LDS_WAIT(); asm volatile("" ::: "memory");
}
__device__ __forceinline__ void p2_post(const Args& a, int l, int gw, int NGW, int lane) {
    const bf16* P = (const bf16*)(a.ws + WS_PROJ); const bf16* GP = (const bf16*)(a.ws + WS_GP); bf16* Y = (bf16*)(a.ws + WS_Y);
    const float* rnw = a.in[6] + (size_t)l * RH * HD; const float* gnw = a.in[7] + (size_t)l * HD;
    const int d0 = 2 * lane;
    for (int m = gw; m < M; m += NGW) {
        for (int hh = 0; hh < NSH; ++hh) {
            const unsigned ou = (hh < RH) ? *(const unsigned*)(P + (size_t)m * NP + C_RV + hh * HD + d0) : *(const unsigned*)(GP + (size_t)m * 2304 + 1536 + (hh - RH) * HD + d0);
            const float ox = bflo(ou), oy = bfhi(ou);
            const float ms = wave_sum(ox * ox + oy * oy) * (1.f / HD);
            const float r = 1.0f / sqrtf(ms + RMS_EPS);
            const float2 w = (hh < RH) ? *(const float2*)(rnw + hh * HD + d0) : *(const float2*)(gnw + d0);
            const int gcol = (hh < RH) ? (C_RG + hh * HD + d0) : (C_GZ + (hh - RH) * HD + d0);
            const int ycol = (hh < RH) ? (hh * HD + d0) : (512 + (hh - RH) * HD + d0);
            const unsigned zu = *(const unsigned*)(P + (size_t)m * NP + gcol);
            *(unsigned*)(Y + (size_t)m * DM + ycol) = pk2(ox * r * w.x * silu_f(bflo(zu)), oy * r * w.y * silu_f(bfhi(zu)));
        }
    }
}

constexpr int PH_PER_LAYER = 7, N_PHASES = DEPTH * PH_PER_LAYER;
__global__ void __launch_bounds__(NTHREADS, 2) hymba_fwd(Args args) {
    extern __shared__ __attribute__((aligned(16))) unsigned char lds_raw[];
    LAS unsigned char* lds = (LAS unsigned char*)lds_raw;
    {   const int tid0 = threadIdx.x;
        for (int u = tid0; u < (LDS_BYTES - LDSCTL_OFF) / 4; u += NTHREADS) ((LAS unsigned*)(lds + LDSCTL_OFF))[u] = 0u; }
    __syncthreads();
    XcdBarrier bar = xcd_barrier_post((unsigned*)(args.ws + WS_CTL) + CW_BAR, (volatile LAS unsigned*)(lds + MISC_OFF) + 8);
    const int lo = args.ph_lo, hi = args.ph_hi;
#pragma unroll 1
    for (int ph = lo; ph < hi; ++ph) {
        const int l = ph / PH_PER_LAYER, k = ph - l * PH_PER_LAYER;
        int tid = threadIdx.x; asm volatile("" : "+v"(tid));
        const int lane = tid & 63, wave = __builtin_amdgcn_readfirstlane(tid >> 6);
        const int G = gridDim.x, bx = blockIdx.x;
        const int vcu = (G % 8 == 0) ? (bx % 8) * (G / 8) + bx / 8 : bx;
        const int gw = vcu * NWAVES + wave, NGW = G * NWAVES;
        const float* xin = (l == 0) ? args.in[0] : args.out;
        switch (k) {
        case 0: { if (l == 0) p0_weights(args, lds, gw, NGW, wave, lane); p0_rows(args, l, xin, lds, gw, NGW, tid, lane); } break;
        case 1: {
            pg8::Gemm g{(const bf16*)(args.ws + WS_H), (const bf16*)(args.ws + WS_WIN) + (size_t)l * NP * DM, M, NP, DM}; pg8::StaticOrder S; S.init(M, NP, G, bx);
            pg8::EpiBf16 E{(bf16*)(args.ws + WS_PROJ), NP};
            pg8::gemm_phase<pg8::EpiBf16, pg8::StaticOrder, true, true>(lds + RING_OFF, g, S, E, tid);
        } break;
        case 2: p2_prep(args, l, gw, NGW, lane); break;
        case 3: p2_kmean(args, gw, NGW, lane); break;
        case 4: {
            if (wave == 0) { for (int it = bx; it < 4 * BATCH * NSH; it += G) p2_scan_item(args, it, lane); }
            else { LAS float* pbuf = (LAS float*)(lds + RING_OFF) + wave * 1024;
                for (int qi = bx * 7 + (wave - 1); qi < BATCH * MH * T; qi += G * 7) p2_moba_query(args, l, qi, pbuf, lane); }
        } break;
        case 5: p2_post(args, l, gw, NGW, lane); break;
        default: {
            pg8::Gemm g{(const bf16*)(args.ws + WS_Y), (const bf16*)(args.ws + WS_WOUT) + (size_t)l * DM * DM, M, DM, DM}; pg8::StaticOrder S; S.init(M, DM, G, bx);
            pg8::EpiResF32 E{args.out, xin, DM};
            pg8::gemm_phase<pg8::EpiResF32, pg8::StaticOrder, true, true>(lds + RING_OFF, g, S, E, tid);
        } break;
        }
        if (ph + 1 < hi) xcd_barrier(bar);
    }
}

#ifndef RUN_PHASES
#define RUN_PHASES N_PHASES
#endif
#ifndef MK_N_LAUNCHES
#define MK_N_LAUNCHES 1
#endif
extern "C" void kernel_launch(void* const* d_in, const int* in_sizes, int n_in, void* d_out, int out_size, void* d_ws, size_t ws_size, hipStream_t stream) {
    static int grid = 0;
    if (grid == 0) {
        if (n_in != 11 || in_sizes[0] != M * DM || out_size != M * DM || ws_size < WS_END) { fprintf(stderr, "kernel_launch: unexpected shapes (n_in %d, in0 %d, out %d, ws %zu)\n", n_in, n_in > 0 ? in_sizes[0] : -1, out_size, ws_size); grid = -1; return; }
        int dev = 0, cus = 0, per_cu = 0;
        if (hipGetDevice(&dev) != hipSuccess || hipDeviceGetAttribute(&cus, hipDeviceAttributeMultiprocessorCount, dev) != hipSuccess) { grid = -1; return; }
        if (hipFuncSetAttribute((const void*)hymba_fwd, hipFuncAttributeMaxDynamicSharedMemorySize, LDS_BYTES) != hipSuccess) { fprintf(stderr, "kernel_launch: hipFuncSetAttribute failed\n"); grid = -1; return; }
        if (hipOccupancyMaxActiveBlocksPerMultiprocessor(&per_cu, (const void*)hymba_fwd, NTHREADS, LDS_BYTES) != hipSuccess || per_cu < 1) fprintf(stderr, "kernel_launch: occupancy query says %d\n", per_cu);
        (void)hipGetLastError();
        grid = cus;
    }
    if (grid < 0) return;
    (void)hipMemsetAsync((char*)d_ws + WS_CTL, 0, CTL_ZERO_BYTES, stream);
    Args a{};
    for (int i = 0; i < 11; ++i) a.in[i] = (const float*)d_in[i];
    a.out = (float*)d_out; a.ws = (unsigned char*)d_ws;
    constexpr int NL = MK_N_LAUNCHES;
    for (int li = 0; li < NL; ++li) {
        a.ph_lo = (NL == 1) ? 0 : li; a.ph_hi = (NL == 1) ? RUN_PHASES : li + 1;
        hipLaunchKernelGGL(hymba_fwd, dim3(grid), dim3(NTHREADS), LDS_BYTES, stream, a);
    }
}
```

```cpp
#include <hip/hip_runtime.h>
#include <cstdio>
#include <cstdint>
namespace pg8 {
#define PG8_LAS __attribute__((address_space(3)))
typedef unsigned short bf16_t;
typedef short bf16x8 __attribute__((ext_vector_type(8)));
typedef float f32x4 __attribute__((ext_vector_type(4)));
typedef unsigned u32x4 __attribute__((ext_vector_type(4)));
constexpr int BM = 256, BK = 64, HALF = 128, HTB = HALF * BK * 2  , STAGE_BYTES = 8 * HTB, NXCD = 8, WGM = 8;

__host__ __device__ __forceinline__ int lds_byte(int r, int c) { const int st = (r >> 4) * 2 + (c >> 5), rr = r & 15, cc = c & 31, ob = rr * 64 + cc * 2; return st * 1024 + (ob ^ (((ob >> 9) & 1) << 5)); }
__host__ __device__ __forceinline__ void stage_rc(int b, int& R, int& C) { const int st = b / 1024, sb = b % 1024, swz = sb ^ (((sb >> 9) & 1) << 5); R = (st >> 1) * 16 + swz / 64; C = (st & 1) * 32 + (swz % 64) / 2; }
__host__ __device__ __forceinline__ int perm32(int rho) { const int n = rho >> 4, i = rho & 15; return 8 * (i >> 2) + 4 * n + (i & 3); }

struct Unit { int pm, pn; };
struct Gemm { const bf16_t* A; const bf16_t* Bt; int M, N, K; };

struct StaticOrder {
    int nM, nN, nwg, G, c;
    __host__ __device__ void init(int M, int N, int G_, int c_) { nM = M / BM; nN = N / BM; nwg = nM * nN; G = G_; c = c_; }
    __host__ __device__ bool next(int i, Unit& u) const {
        const long L = (long)i * G + c; if (L >= nwg) return false;
        int wgid = (int)L; { const int q = nwg / NXCD, r = nwg % NXCD, xcd = wgid % NXCD, off = wgid / NXCD; wgid = (xcd < r ? xcd * (q + 1) : r * (q + 1) + (xcd - r) * q) + off; }
        const int nig = WGM * nN, gid = wgid / nig, fm = gid * WGM, gsz = (nM - fm) < WGM ? (nM - fm) : WGM;
        u.pm = fm + ((wgid % nig) % gsz); u.pn = (wgid % nig) / gsz; return true;
    }
    __device__ __forceinline__ void a_ready(const Unit&) const {}
    __device__ __forceinline__ void done(const Unit&) const {}
};

__device__ __forceinline__ unsigned cvt_pk_bf16(float lo, float hi) { unsigned r; asm volatile("v_cvt_pk_bf16_f32 %0, %1, %2" : "=v"(r) : "v"(lo), "v"(hi)); return r; }
__device__ __forceinline__ float silu_ep(float x) { return x * __builtin_amdgcn_rcpf(1.f + __builtin_amdgcn_exp2f(-1.4426950408889634f * x)); }
constexpr size_t M_ROWS = 16384;
struct EpiBf16 {
    static constexpr bool PERM = true, AFTER_DRAIN = false;
    bf16_t* O; int ldc; unsigned gate_tiles;
    __device__ __forceinline__ void operator()(const f32x4 (&acc)[2][2][4][2], const Unit& u, int wr, int wc, int fr, int fq) const {
        const int row0 = u.pm * BM + wr * 64 + fr; const int col0 = u.pn * BM + wc * 32 + 8 * fq;
        const bool gate = ((gate_tiles >> u.pn) & 1u) != 0u;
#pragma unroll
        for (int ai = 0; ai < 2; ++ai)
#pragma unroll
            for (int m = 0; m < 4; ++m) { const size_t row = (size_t)(row0 + ai * HALF + m * 16); bf16_t* rowp = O + row * ldc + col0;
#pragma unroll
                for (int bj = 0; bj < 2; ++bj) { f32x4 v0 = acc[ai][bj][m][0], v1 = acc[ai][bj][m][1];
                    if (gate) { v0[0] = silu_ep(v0[0]); v0[1] = silu_ep(v0[1]); v0[2] = silu_ep(v0[2]); v0[3] = silu_ep(v0[3]); v1[0] = silu_ep(v1[0]); v1[1] = silu_ep(v1[1]); v1[2] = silu_ep(v1[2]); v1[3] = silu_ep(v1[3]); }
                    u32x4 w; w.x = cvt_pk_bf16(v0[0], v0[1]); w.y = cvt_pk_bf16(v0[2], v0[3]); w.z = cvt_pk_bf16(v1[0], v1[1]); w.w = cvt_pk_bf16(v1[2], v1[3]);
                    if (ldc) *(u32x4*)(rowp + bj * HALF) = w;
                    else *(u32x4*)(O + ((size_t)(2 * u.pn + bj) * M_ROWS + row) * 128 + wc * 32 + 8 * fq) = w; } }
    }
};
struct EpiResF32 {
    static constexpr bool PERM = false, AFTER_DRAIN = false;
    float* C; const float* R; int ldc;
    __device__ __forceinline__ void operator()(const f32x4 (&acc)[2][2][4][2], const Unit& u, int wr, int wc, int fr, int fq) const {
        const int row0 = u.pm * BM + wr * 64 + fr, col0 = u.pn * BM + wc * 32 + 4 * fq;
#pragma unroll
        for (int ai = 0; ai < 2; ++ai) {
            f32x4 r[4][2][2];
#pragma unroll
            for (int m = 0; m < 4; ++m) { const size_t off = (size_t)(row0 + ai * HALF + m * 16) * ldc + col0;
#pragma unroll
                for (int bj = 0; bj < 2; ++bj)
#pragma unroll
                    for (int n = 0; n < 2; ++n) r[m][bj][n] = *(const f32x4*)(R + off + bj * HALF + n * 16); }
#pragma unroll
            for (int m = 0; m < 4; ++m) { const size_t off = (size_t)(row0 + ai * HALF + m * 16) * ldc + col0;
#pragma unroll
                for (int bj = 0; bj < 2; ++bj)
#pragma unroll
                    for (int n = 0; n < 2; ++n) *(f32x4*)(C + off + bj * HALF + n * 16) = r[m][bj][n] + acc[ai][bj][m][n]; }
        }
    }
};
template <class Epi, class Sched, bool ALIGN_EPI = false, bool SP2 = false>
__device__ __forceinline__ void gemm_phase(PG8_LAS unsigned char* lds, const Gemm g, const Sched& S, const Epi& E, const int tid) {
    const int  wid = __builtin_amdgcn_readfirstlane(tid >> 6), lane = tid & 63, wr = wid >> 2, wc = wid & 3, fr = lane & 15, fq = lane >> 4;
    const int K = g.K, nt = K / BK;
    unsigned voffA[2], voffB[2];
#pragma unroll
    for (int i = 0; i < 2; ++i) { int R, C; stage_rc(tid * 16 + i * 8192, R, C); const int Rb = Epi::PERM ? ((R & ~31) + perm32(R & 31)) : R;
        voffA[i] = (unsigned)(R * K + C) * 2u; voffB[i] = (unsigned)(Rb * K + C) * 2u; }
    const size_t kstep = (size_t)(BK * 2);
    const size_t hstep = (size_t)HALF * K * 2;
    const size_t tstep = 2 * hstep;
    const unsigned ldsw = (unsigned)wid * 1024u;
    const int aoff = lds_byte(wr * 64 + fr, fq * 8), boff = lds_byte(wc * 32 + fr, fq * 8);
#define PG8_SA(b, h) (((b) * 2 + (h)) * HTB)
#define PG8_SB(b, h) ((4 + (b) * 2 + (h)) * HTB)
#define PG8_STAGE(bufoff, gbase, voff) do { _Pragma("unroll") for (int _i = 0; _i < 2; ++_i) \
        __builtin_amdgcn_global_load_lds((const unsigned*)((const char*)(gbase) + (voff)[_i]), (PG8_LAS unsigned*)(lds + (bufoff) + ldsw + _i * 8192), 16, 0, 0); } while (0)
#define PG8_LDA(dst, b, h) do { _Pragma("unroll") for (int m = 0; m < 4; ++m) _Pragma("unroll") for (int k = 0; k < 2; ++k) dst[m][k] = *(const PG8_LAS bf16x8*)(lds + PG8_SA(b, h) + aoff + m * 2048 + k * 1024); } while (0)
#define PG8_LDB(dst, b, h) do { _Pragma("unroll") for (int n = 0; n < 2; ++n) _Pragma("unroll") for (int k = 0; k < 2; ++k) dst[n][k] = *(const PG8_LAS bf16x8*)(lds + PG8_SB(b, h) + boff + n * 2048 + k * 1024); } while (0)
#define PG8_MMA(ai, bj, At, Bt) do { __builtin_amdgcn_s_setprio(1); _Pragma("unroll") for (int m = 0; m < 4; ++m) _Pragma("unroll") for (int n = 0; n < 2; ++n) _Pragma("unroll") for (int k = 0; k < 2; ++k) \
        acc[ai][bj][m][n] = __builtin_amdgcn_mfma_f32_16x16x32_bf16(Bt[n][k], At[m][k], acc[ai][bj][m][n], 0, 0, 0); __builtin_amdgcn_s_setprio(0); } while (0)
#define PG8_WAIT_V(n) asm volatile("s_waitcnt vmcnt(" #n ")" ::: "memory")
#define PG8_WAIT_L(n) asm volatile("s_waitcnt lgkmcnt(" #n ")" ::: "memory")
#define PG8_BAR __builtin_amdgcn_s_barrier()
#define PG8_SCHED __builtin_amdgcn_sched_barrier(0)
    Unit cur, nxt; int ui = 0;
    if (!S.next(0, cur)) return;
    f32x4 acc[2][2][4][2];
#pragma unroll
    for (int a = 0; a < 2; ++a)
#pragma unroll
        for (int b = 0; b < 2; ++b)
#pragma unroll
            for (int m = 0; m < 4; ++m)
#pragma unroll
                for (int n = 0; n < 2; ++n) acc[a][b][m][n] = (f32x4){0.f, 0.f, 0.f, 0.f};
    bf16x8 At[4][2], B0[2][2], B1[2][2];
    const char* cA = (const char*)g.A + (size_t)cur.pm * tstep; const char* cB = (const char*)g.Bt + (size_t)cur.pn * tstep;
    S.a_ready(cur);
    if constexpr (SP2) {
        PG8_STAGE(PG8_SB(0, 0), cB, voffB); PG8_STAGE(PG8_SB(0, 1), cB + hstep, voffB); PG8_STAGE(PG8_SA(0, 0), cA, voffA); PG8_STAGE(PG8_SA(0, 1), cA + hstep, voffA);
        if (wr == 1) PG8_BAR;
        PG8_WAIT_V(2); PG8_BAR;
        PG8_STAGE(PG8_SB(1, 0), cB + kstep, voffB); PG8_STAGE(PG8_SA(1, 0), cA + kstep, voffA); PG8_STAGE(PG8_SB(1, 1), cB + hstep + kstep, voffB);
        PG8_WAIT_V(6); PG8_BAR;
    } else {
        PG8_STAGE(PG8_SB(0, 0), cB, voffB); PG8_STAGE(PG8_SA(0, 0), cA, voffA); PG8_STAGE(PG8_SB(0, 1), cB + hstep, voffB); PG8_STAGE(PG8_SA(0, 1), cA + hstep, voffA);
        if (wr == 1) PG8_BAR;
        PG8_WAIT_V(4); PG8_BAR;
        PG8_STAGE(PG8_SB(1, 0), cB + kstep, voffB); PG8_STAGE(PG8_SA(1, 0), cA + kstep, voffA); PG8_STAGE(PG8_SB(1, 1), cB + hstep + kstep, voffB);
        PG8_WAIT_V(6); PG8_BAR;
    }
    for (;;) {
        const bool has_next = S.next(ui + 1, nxt);
        const char* nA = has_next ? (const char*)g.A + (size_t)nxt.pm * tstep : cA; const char* nB = has_next ? (const char*)g.Bt + (size_t)nxt.pn * tstep : cB;
        for (int t = 0; t < nt; t += 2) {
            const bool last = (t == nt - 2);
            const char* a1 = cA + (size_t)(t + 1) * kstep;
            const char* a2 = last ? nA : cA + (size_t)(t + 2) * kstep; const char* b2 = last ? nB : cB + (size_t)(t + 2) * kstep;
            const char* a3 = a2 + kstep; const char* b3 = b2 + kstep;
            if (last && has_next) S.a_ready(nxt);
            if constexpr (SP2) {
            PG8_LDB(B0, 0, 0); PG8_LDB(B1, 0, 1); PG8_SCHED; PG8_LDA(At, 0, 0); PG8_STAGE(PG8_SA(1, 1), a1 + hstep, voffA);
            PG8_WAIT_V(8); PG8_WAIT_L(0); PG8_BAR; PG8_MMA(0, 0, At, B0); PG8_MMA(0, 1, At, B1); PG8_BAR; PG8_SCHED;
            PG8_LDA(At, 0, 1); PG8_STAGE(PG8_SB(0, 0), b2, voffB); PG8_STAGE(PG8_SB(0, 1), b2 + hstep, voffB); PG8_STAGE(PG8_SA(0, 0), a2, voffA);
            PG8_WAIT_V(8); PG8_WAIT_L(0); PG8_BAR; PG8_MMA(1, 0, At, B0); PG8_MMA(1, 1, At, B1); PG8_BAR; PG8_SCHED;
            PG8_LDB(B0, 1, 0); PG8_LDB(B1, 1, 1); PG8_SCHED; PG8_LDA(At, 1, 0); PG8_STAGE(PG8_SA(0, 1), a2 + hstep, voffA);
            PG8_WAIT_V(8); PG8_WAIT_L(0); PG8_BAR; PG8_MMA(0, 0, At, B0); PG8_MMA(0, 1, At, B1); PG8_BAR; PG8_SCHED;
            PG8_LDA(At, 1, 1); PG8_STAGE(PG8_SB(1, 0), b3, voffB); PG8_STAGE(PG8_SB(1, 1), b3 + hstep, voffB); PG8_STAGE(PG8_SA(1, 0), a3, voffA);
            PG8_WAIT_V(8); PG8_WAIT_L(0); PG8_BAR; PG8_MMA(1, 0, At, B0); PG8_MMA(1, 1, At, B1); PG8_BAR; PG8_SCHED;
            } else {
            PG8_LDB(B0, 0, 0); PG8_SCHED; PG8_LDA(At, 0, 0); PG8_STAGE(PG8_SA(1, 1), a1 + hstep, voffA);
            PG8_WAIT_L(8); PG8_BAR; PG8_WAIT_L(0); PG8_MMA(0, 0, At, B0); PG8_BAR; PG8_SCHED;
            PG8_LDB(B1, 0, 1); PG8_STAGE(PG8_SB(0, 0), b2, voffB);
            PG8_BAR; PG8_WAIT_L(0); PG8_MMA(0, 1, At, B1); PG8_BAR;
            PG8_LDA(At, 0, 1); PG8_STAGE(PG8_SA(0, 0), a2, voffA);
            PG8_BAR; PG8_WAIT_L(0); PG8_MMA(1, 0, At, B0); PG8_BAR; PG8_SCHED;
            PG8_STAGE(PG8_SB(0, 1), b2 + hstep, voffB);
            PG8_WAIT_V(6); PG8_BAR; PG8_MMA(1, 1, At, B1); PG8_BAR;
            PG8_LDB(B0, 1, 0); PG8_SCHED; PG8_LDA(At, 1, 0); PG8_STAGE(PG8_SA(0, 1), a2 + hstep, voffA);
            PG8_WAIT_L(8); PG8_BAR; PG8_WAIT_L(0); PG8_MMA(0, 0, At, B0); PG8_BAR; PG8_SCHED;
            PG8_LDB(B1, 1, 1); PG8_STAGE(PG8_SB(1, 0), b3, voffB);
            PG8_BAR; PG8_WAIT_L(0); PG8_MMA(0, 1, At, B1); PG8_BAR;
            PG8_LDA(At, 1, 1); PG8_STAGE(PG8_SA(1, 0), a3, voffA);
            PG8_BAR; PG8_WAIT_L(0); PG8_MMA(1, 0, At, B0); PG8_BAR; PG8_SCHED;
            PG8_STAGE(PG8_SB(1, 1), b3 + hstep, voffB);
            PG8_WAIT_V(6); PG8_BAR; PG8_MMA(1, 1, At, B1); PG8_BAR;
            }
        }
        if constexpr (ALIGN_EPI) { if (wr == 0) PG8_BAR; }
        if constexpr (!Epi::AFTER_DRAIN) { E(acc, cur, wr, wc, fr, fq); S.done(cur); }
        if (!has_next) break;
#pragma unroll
        for (int a = 0; a < 2; ++a)
#pragma unroll
            for (int b = 0; b < 2; ++b)
#pragma unroll
                for (int m = 0; m < 4; ++m)
#pragma unroll
                    for (int n = 0; n < 2; ++n) acc[a][b][m][n] = (f32x4){0.f, 0.f, 0.f, 0.f};
        cur = nxt; cA = nA; cB = nB; ++ui;
        if constexpr (ALIGN_EPI) { if (wr == 1) PG8_BAR; }
    }
    PG8_WAIT_V(0);
    if constexpr (!ALIGN_EPI) { if (wr == 0) PG8_BAR; }
    PG8_BAR;
    if constexpr (Epi::AFTER_DRAIN) { E.fused(acc, cur, wr, wc, fr, fq, lds, wid, lane); S.done(cur); }
#undef PG8_SA
#undef PG8_SB
#undef PG8_STAGE
#undef PG8_LDA
#undef PG8_LDB
#undef PG8_MMA
#undef PG8_WAIT_V
#undef PG8_WAIT_L
#undef PG8_BAR
#undef PG8_SCHED
}
}
#define GAS __attribute__((address_space(1)))
#define LAS __attribute__((address_space(3)))
typedef unsigned short bf16;
typedef unsigned v4u __attribute__((ext_vector_type(4)));
typedef float f32x4 __attribute__((ext_vector_type(4)));
typedef short bf16x8 __attribute__((ext_vector_type(8)));
typedef GAS unsigned gu32;
typedef GAS unsigned long long gu64;
#define RLX_AGENT __ATOMIC_RELAXED, __HIP_MEMORY_SCOPE_AGENT
#define LDS_WAIT() asm volatile("s_waitcnt lgkmcnt(0)" ::: "memory")
#define VM_WAIT() asm volatile("s_waitcnt vmcnt(0)" ::: "memory")
__device__ __forceinline__ unsigned long long rt() { return __builtin_amdgcn_s_memrealtime(); }
__device__ __forceinline__ unsigned f2bf(float f) { unsigned u = __builtin_bit_cast(unsigned, f); return (u + 0x7fffu + ((u >> 16) & 1u)) >> 16; }
__device__ __forceinline__ unsigned pk2(float lo, float hi) { return f2bf(lo) | (f2bf(hi) << 16); }

#define XB_TMO      128
#define XB_XCNT(j)  (256  + 64 * (j))
#define XB_XSUB(j)  (1280 + 64 * (j))
#define XB_XGEN(j)  (2304 + 64 * (j))
#define XB_TOP      3328
#define XB_TOPGEN   3392
#define XCD_BAR_WORDS 3456
#define XB_SPIN_CAP (1u << 18)

__device__ __forceinline__ unsigned xb_ld(unsigned* p)              { return __hip_atomic_load(p, __ATOMIC_RELAXED, __HIP_MEMORY_SCOPE_AGENT); }
__device__ __forceinline__ unsigned xb_add(unsigned* p, unsigned v) { return __hip_atomic_fetch_add(p, v, __ATOMIC_RELAXED, __HIP_MEMORY_SCOPE_AGENT); }
__device__ __forceinline__ unsigned xb_xcc_id() { return (unsigned)__builtin_amdgcn_s_getreg((3 << 11) | 20) & 0xFu; }
#define XB_SPIN(cond, bar) do { unsigned _sp = 0; while (cond) { __builtin_amdgcn_s_sleep(1); \
    if ((++_sp & 255u) == 0u) { if (xb_ld(&(bar)[XB_TMO])) break; if (_sp > XB_SPIN_CAP) { atomicAdd(&(bar)[XB_TMO], 1u); break; } } } } while (0)

struct XcdBarrier {
    unsigned* bar; unsigned x;
    volatile LAS unsigned* st;
};

__device__ __forceinline__ XcdBarrier xcd_barrier_post(unsigned* bar, volatile LAS unsigned* st) {
    XcdBarrier b; b.bar = bar; b.x = xb_xcc_id(); b.st = st;
    if (threadIdx.x == 0) (void)xb_add(&bar[XB_XCNT(b.x)], 1u);
    return b;
}
__device__ __forceinline__ void xcd_barrier_complete(unsigned* bar, unsigned x, unsigned& nloc, unsigned& nx) {
    const unsigned G = gridDim.x * gridDim.y * gridDim.z;
    unsigned sum, cnt, mine, sp = 0u;
    for (;;) {
        sum = 0u; cnt = 0u; mine = 0u;
#pragma unroll
        for (unsigned j = 0; j < 16; ++j) { const unsigned c = xb_ld(&bar[XB_XCNT(j)]); sum += c; cnt += (c > 0u) ? 1u : 0u; mine = (j == x) ? c : mine; }
        if (sum == G) break;
        __builtin_amdgcn_s_sleep(1);
        if ((++sp & 255u) == 0u) { if (xb_ld(&bar[XB_TMO])) break; if (sp > XB_SPIN_CAP) { atomicAdd(&bar[XB_TMO], 1u); break; } }
    }
    nloc = mine > 0u ? mine : 1u; nx = cnt > 0u ? cnt : 1u;
}

__device__ __forceinline__ void xcd_barrier(const XcdBarrier& b) {
    asm volatile("s_waitcnt vmcnt(0)" ::: "memory");
    __syncthreads();
    if (threadIdx.x == 0) {
        unsigned* bar = b.bar;
        __builtin_amdgcn_s_waitcnt(0);
        unsigned nloc = b.st[0], nx = b.st[1];
        if (nloc == 0u) { xcd_barrier_complete(bar, b.x, nloc, nx); b.st[0] = nloc; b.st[1] = nx; }
        const unsigned old = xb_add(&bar[XB_XSUB(b.x)], 1u);
        const unsigned gen = old / nloc;
        if (old + 1u == (gen + 1u) * nloc) {
            __builtin_amdgcn_fence(__ATOMIC_RELEASE, "agent");
            asm volatile("s_waitcnt vmcnt(0)" ::: "memory");
            const unsigned og = xb_add(&bar[XB_TOP], 1u);
            const unsigned tg = og / nx;
            if (og + 1u == (tg + 1u) * nx) xb_add(&bar[XB_TOPGEN], 1u);
            else XB_SPIN(xb_ld(&bar[XB_TOPGEN]) == tg, bar);
            __builtin_amdgcn_fence(__ATOMIC_ACQUIRE, "agent");
            xb_add(&bar[XB_XGEN(b.x)], 1u);
            asm volatile("s_waitcnt vmcnt(0)" ::: "memory");
        } else {
            XB_SPIN(xb_ld(&bar[XB_XGEN(b.x)]) == gen, bar);
            __builtin_amdgcn_fence(__ATOMIC_ACQUIRE, "agent");
            asm volatile("s_waitcnt vmcnt(0)" ::: "memory");
        }
    }
    __syncthreads();
}

constexpr int NWAVES = 8, NTHREADS = NWAVES * 64;
constexpr int BATCH = 2, T = 8192, DM = 2048, M = BATCH * T, HD = 128, RH = 4, GH = 6, MH = 6, NP = 8192, INW = 8204, DEPTH = 2;
constexpr int C_RQ = 0, C_RK = 512, C_RV = 1024, C_RG = 1536, C_GQ = 2048, C_GK = 2816, C_GV = 3584, C_GZ = 4352, C_MQ = 5120, C_MK = 5888, C_MV = 6656, C_MZ = 7424;
constexpr int NSH = 10;
constexpr float RMS_EPS = 1e-6f;
constexpr int MOBA_BLK = 256, MOBA_NB = T / MOBA_BLK;

constexpr size_t MiB = 1u << 20;
constexpr size_t WS_CTL = 0, CTL_ZERO_BYTES = 192 * 1024;
constexpr size_t WS_WIN = 2 * MiB;
constexpr size_t WS_WOUT = 34 * MiB;
constexpr size_t WS_H = 42 * MiB;
constexpr size_t WS_Y = 42 * MiB;
constexpr size_t WS_GAB = 106 * MiB;
constexpr size_t WS_KMEAN = 107 * MiB;
constexpr size_t WS_PROJ = 108 * MiB;
constexpr size_t WS_GQ = 364 * MiB, WS_GK = 388 * MiB, WS_GV = 412 * MiB, WS_GW = 436 * MiB;
constexpr size_t WS_QKD = 460 * MiB;
constexpr size_t WS_EGS = 480 * MiB;
constexpr size_t WS_ALPHA = 481 * MiB;
constexpr size_t WS_END = 500 * MiB;
constexpr int CW_TMO = 0, CW_CODE = 1, CW_BAR = 4096, CW_QUEUE = 8192, CW_MBCNT = 32768;

constexpr int RING_OFF = 0, RING_BYTES = 131072;
constexpr int QW_OFF = 145408;
constexpr int LDSCTL_OFF = 146432, MISC_OFF = LDSCTL_OFF + 320;
constexpr int LDS_BYTES = 147456;

__device__ __forceinline__ float dpp_f(float v, const int ctrl) { return v; }
#define DPP_ADD(v, ctrl) ((v) + __builtin_bit_cast(float, __builtin_amdgcn_update_dpp(0, __builtin_bit_cast(int, (v)), (ctrl), 0xF, 0xF, true)))
__device__ __forceinline__ float wave_sum(float v) {
    v = DPP_ADD(v, 0xB1);
    v = DPP_ADD(v, 0x4E);
    v = DPP_ADD(v, 0x141);
    v = DPP_ADD(v, 0x140);
    v += __builtin_bit_cast(float, __builtin_amdgcn_update_dpp(0, __builtin_bit_cast(int, v), 0x142, 0xA, 0xF, false));
    v += __builtin_bit_cast(float, __builtin_amdgcn_update_dpp(0, __builtin_bit_cast(int, v), 0x143, 0xC, 0xF, false));
    return __builtin_bit_cast(float, __builtin_amdgcn_readlane(__builtin_bit_cast(int, v), 63));
}
__device__ __forceinline__ float wave_max(float v) {
#pragma unroll
    for (int o = 1; o < 64; o <<= 1) v = fmaxf(v, __shfl_xor(v, o));
    return v;
}
__device__ __forceinline__ float bf2f(unsigned short u) { return __builtin_bit_cast(float, (unsigned)u << 16); }
__device__ __forceinline__ float bflo(unsigned u) { return __builtin_bit_cast(float, u << 16); }
__device__ __forceinline__ float bfhi(unsigned u) { return __builtin_bit_cast(float, u & 0xffff0000u); }
__device__ __forceinline__ float silu_f(float x) { return x / (1.f + expf(-x)); }
__device__ __forceinline__ float silu_fast(float x) { return x * __builtin_amdgcn_rcpf(1.f + __builtin_amdgcn_exp2f(-1.4426950408889634f * x)); }
__device__ __forceinline__ float fexp(float x) { return __builtin_amdgcn_exp2f(1.4426950408889634f * x); }
__device__ __forceinline__ float frsq(float x) { return __builtin_amdgcn_rsqf(x); }

typedef short s16x4 __attribute__((ext_vector_type(4)));
typedef float f32x2v __attribute__((ext_vector_type(2)));
typedef __bf16 bf2v __attribute__((ext_vector_type(2)));
__device__ __forceinline__ unsigned pkbf(float a, float b) { const f32x2v v = {a, b}; const bf2v r = __builtin_convertvector(v, bf2v); return __builtin_bit_cast(unsigned, r); }
__device__ __forceinline__ bf16x8 pack8(const f32x4 a, const f32x4 b) { v4u p; p.x = pkbf(a.x, a.y); p.y = pkbf(a.z, a.w); p.z = pkbf(b.x, b.y); p.w = pkbf(b.z, b.w); return __builtin_bit_cast(bf16x8, p); }
__device__ __forceinline__ bf16x8 ldA2(const LAS unsigned char* p) { const s16x4 lo = *(const volatile LAS s16x4*)p; const s16x4 hi = *(const volatile LAS s16x4*)(p + 32); return __builtin_shufflevector(lo, hi, 0, 1, 2, 3, 4, 5, 6, 7); }
#define MFMA16(a, b, c) __builtin_amdgcn_mfma_f32_16x16x32_bf16((a), (b), (c), 0, 0, 0)
constexpr int NCH = T / 64;
constexpr int SB_SPLIT = 80;

#define PG(P, g) ((P) + (size_t)(g) * M * HD)
constexpr int G_RQ = 0, G_RK = 4, G_RV = 8, G_RG = 12, G_GQ = 16, G_GK = 22, G_GV = 28, G_GZ = 34, G_MQ = 40, G_MK = 46, G_MV = 52, G_MZ = 58;

struct Args { const float* in[11]; float* out; unsigned char* ws; int ph_lo, ph_hi; };

struct TItem { const float* src; bf16* dst; int ldw; };
__device__ __forceinline__ TItem p0_item(const Args& a, int l, int it) {
    constexpr int I_IN = (DM / 64) * (NP / 32);
    TItem t;
    if (it < I_IN) { const int kb = it / (NP / 32), nb = it % (NP / 32), n0 = 32 * nb; const int src = n0 + (n0 >= 5120 ? 12 : 0);
        t.src = a.in[2] + (size_t)l * DM * INW + (size_t)(64 * kb) * INW + src; t.ldw = INW; t.dst = (bf16*)(a.ws + WS_WIN) + (size_t)n0 * DM + 64 * kb; }
    else { const int r = it - I_IN; const int kb = r / (DM / 32), nb = r % (DM / 32), n0 = 32 * nb;
        t.src = a.in[10] + (size_t)l * DM * DM + (size_t)(64 * kb) * DM + n0; t.ldw = DM; t.dst = (bf16*)(a.ws + WS_WOUT) + (size_t)n0 * DM + 64 * kb; }
    return t;
}
__device__ __forceinline__ void p0_weights(const Args& a, int l, LAS unsigned char* lds, int gw, int NGW, int wave, int lane) {
    LAS float* scr = (LAS float*)(lds + RING_OFF + wave * 16384);
    constexpr int NITEMS = (DM / 64) * (NP / 32) + (DM / 64) * (DM / 32);
    f32x4 nv[8]; TItem cur, nxt;
    if (gw < NITEMS) { cur = p0_item(a, l, gw);
#pragma unroll
        for (int i = 0; i < 8; ++i) { const int p = lane + 64 * i; nv[i] = *(const f32x4*)(cur.src + (size_t)(p >> 3) * cur.ldw + 4 * (p & 7)); } }
    for (int it = gw; it < NITEMS; it += NGW) {
        f32x4 v[8];
#pragma unroll
        for (int i = 0; i < 8; ++i) v[i] = nv[i];
        if (it + NGW < NITEMS) { nxt = p0_item(a, l, it + NGW);
#pragma unroll
            for (int i = 0; i < 8; ++i) { const int p = lane + 64 * i; nv[i] = *(const f32x4*)(nxt.src + (size_t)(p >> 3) * nxt.ldw + 4 * (p & 7)); } }
#pragma unroll
        for (int i = 0; i < 8; ++i) { const int p = lane + 64 * i, kk = p >> 3, c4 = p & 7; LAS float* d = scr + kk * 33 + 4 * c4; d[0] = v[i].x; d[1] = v[i].y; d[2] = v[i].z; d[3] = v[i].w; }
        LDS_WAIT(); asm volatile("" ::: "memory");
        const int c = lane & 7;
#pragma unroll
        for (int j = 0; j < 4; ++j) { const int n = (lane >> 3) + 8 * j; const LAS float* s = scr + (8 * c) * 33 + n;
            v4u o; o.x = pkbf(s[0 * 33], s[1 * 33]); o.y = pkbf(s[2 * 33], s[3 * 33]); o.z = pkbf(s[4 * 33], s[5 * 33]); o.w = pkbf(s[6 * 33], s[7 * 33]);
            *(GAS v4u*)(cur.dst + (size_t)n * DM + 8 * c) = o; }
        LDS_WAIT(); asm volatile("" ::: "memory");
        cur = nxt;
    }
}
__device__ __forceinline__ void p0_rows(const Args& a, int l, const float* xin, LAS unsigned char* lds, int gw, int NGW, int tid, int lane) {
    LAS float* wab = (LAS float*)(lds + RING_OFF);
    const float* win = a.in[2] + (size_t)l * DM * INW;
    __syncthreads();
    {
        f32x4 wv[4][3];
#pragma unroll
        for (int r = 0; r < 4; ++r)
#pragma unroll
            for (int q = 0; q < 3; ++q) wv[r][q] = *(const f32x4*)(win + (size_t)(tid + NTHREADS * r) * INW + 5120 + 4 * q);
#pragma unroll
        for (int r = 0; r < 4; ++r)
#pragma unroll
            for (int q = 0; q < 3; ++q) { const int k = tid + NTHREADS * r; wab[(4 * q) * DM + k] = wv[r][q].x; wab[(4 * q + 1) * DM + k] = wv[r][q].y; wab[(4 * q + 2) * DM + k] = wv[r][q].z; wab[(4 * q + 3) * DM + k] = wv[r][q].w; }
    }
    __syncthreads();
    const float* nw = a.in[1] + (size_t)l * DM;
    bf16* H = (bf16*)(a.ws + WS_H); float* GAB = (float*)(a.ws + WS_GAB);
    f32x4 nwv[8];
#pragma unroll
    for (int j = 0; j < 8; ++j) nwv[j] = ((const f32x4*)nw)[lane + 64 * j];
    f32x4 nx[8];
    if (gw < M) {
#pragma unroll
        for (int j = 0; j < 8; ++j) nx[j] = ((const f32x4*)(xin + (size_t)gw * DM) + lane)[64 * j];
    }
    for (int m = gw; m < M; m += NGW) {
        f32x4 v[8]; float ss = 0.f;
#pragma unroll
        for (int j = 0; j < 8; ++j) { v[j] = nx[j]; ss += (v[j].x * v[j].x + v[j].y * v[j].y) + (v[j].z * v[j].z + v[j].w * v[j].w); }
        if (m + NGW < M) {
#pragma unroll
            for (int j = 0; j < 8; ++j) nx[j] = ((const f32x4*)(xin + (size_t)(m + NGW) * DM) + lane)[64 * j];
        }
        ss = wave_sum(ss);
        const float r = 1.0f / sqrtf(ss * (1.f / DM) + RMS_EPS);
        unsigned long long* o8 = (unsigned long long*)(H + (size_t)m * DM) + lane;
#pragma unroll
        for (int j = 0; j < 8; ++j) {
            v[j] = v[j] * r * nwv[j];
            o8[64 * j] = (unsigned long long)pk2(v[j].x, v[j].y) | ((unsigned long long)pk2(v[j].z, v[j].w) << 32);
        }
        float val = 0.f;
#pragma unroll 1
        for (int c = 0; c < 12; ++c) {
            float s = 0.f; f32x4 wv8[8];
#pragma unroll
            for (int j = 0; j < 8; ++j) wv8[j] = *(const LAS f32x4*)(wab + c * DM + 4 * lane + 256 * j);
            __builtin_amdgcn_sched_barrier(0);
#pragma unroll
            for (int j = 0; j < 8; ++j) s += (v[j].x * wv8[j].x + v[j].y * wv8[j].y) + (v[j].z * wv8[j].z + v[j].w * wv8[j].w);
            s = wave_sum(s); val = (lane == c) ? s : val;
        }
        if (lane < 12) {
            float o;
            if (lane < 6) { const float al = a.in[4][l * GH + lane], db = a.in[5][l * GH + lane]; const float z = val + db;
                const float sp = (z > 20.f) ? z : log1pf(expf(z)); o = -expf(al) * sp; }
            else o = 1.f / (1.f + expf(-val));
            GAB[(size_t)m * 12 + lane] = o;
        }
    }
    __syncthreads();
}

constexpr float MB_C1 = 0.12751743074602468f;
__device__ __forceinline__ void mp_item(const Args& a, int l, int item, LAS unsigned char* lds, int tid, int lane, int wave) {
    bf16* P = (bf16*)(a.ws + WS_PROJ);
    const float* qnw = a.in[8] + l * HD; const float* knw = a.in[9] + l * HD;
    const int b = item / MOBA_NB, blk = item - b * MOBA_NB, d0 = 2 * lane;
    const f32x2v qw = *(const f32x2v*)(qnw + d0), kw = *(const f32x2v*)(knw + d0);
    const size_t mbase = (size_t)b * T + (size_t)blk * MOBA_BLK + 32 * wave;
    bf16* base = P + mbase * HD + d0;
    float ks0[MH], ks1[MH];
#pragma unroll
    for (int h = 0; h < MH; ++h) { ks0[h] = 0.f; ks1[h] = 0.f; }
    unsigned cq[MH], ck[MH], nq[MH], nk[MH];
#pragma unroll
    for (int h = 0; h < MH; ++h) { cq[h] = *(const unsigned*)(PG(base, G_MQ + h)); ck[h] = *(const unsigned*)(PG(base, G_MK + h)); }
#pragma unroll 1
    for (int r = 0; r < 32; ++r) {
        bf16* row = base + (size_t)r * HD;
        if (r + 1 < 32) {
#pragma unroll
            for (int h = 0; h < MH; ++h) { nq[h] = *(const unsigned*)(PG(row + HD, G_MQ + h)); nk[h] = *(const unsigned*)(PG(row + HD, G_MK + h)); }
        }
#pragma unroll
        for (int h = 0; h < MH; ++h) {
            const float q0 = bflo(cq[h]), q1 = bfhi(cq[h]), k0 = bflo(ck[h]), k1 = bfhi(ck[h]);
            const float qs = wave_sum(q0 * q0 + q1 * q1), ks = wave_sum(k0 * k0 + k1 * k1);
            const float qr = frsq(qs * (1.f / HD) + RMS_EPS), kr = frsq(ks * (1.f / HD) + RMS_EPS);
            const float kn0 = k0 * kr * kw.x, kn1 = k1 * kr * kw.y;
            *(unsigned*)(PG(row, G_MQ + h)) = pkbf(q0 * qr * qw.x * MB_C1, q1 * qr * qw.y * MB_C1);
            *(unsigned*)(PG(row, G_MK + h)) = pkbf(kn0, kn1);
            ks0[h] += kn0; ks1[h] += kn1;
        }
#pragma unroll
        for (int h = 0; h < MH; ++h) { cq[h] = nq[h]; ck[h] = nk[h]; }
    }
    __syncthreads();
    LAS float* red = (LAS float*)lds;
#pragma unroll
    for (int h = 0; h < MH; ++h) *(LAS f32x2v*)(red + (wave * MH + h) * HD + d0) = (f32x2v){ks0[h], ks1[h]};
    __syncthreads();
    float* KM = (float*)(a.ws + WS_KMEAN);
    for (int i = tid; i < MH * HD; i += NTHREADS) { const int h = i / HD, d = i - h * HD; float sacc = 0.f;
#pragma unroll
        for (int w = 0; w < NWAVES; ++w) sacc += red[(w * MH + h) * HD + d];
        KM[((size_t)(b * MH + h) * MOBA_NB + blk) * HD + d] = sacc * (1.f / MOBA_BLK); }
    __syncthreads();
}
constexpr int SA_QB = 0, SA_KB = 17408, SA_MF = 34816, SA_GC = 52224, SA_BETA = 52480, SA_KT = 52736, SA_VT = 71168, SA_TBB = 89600, SA_TBE = 98816, SA_VB = 108032;
__device__ __forceinline__ void sa_item(const Args& a, int l, int item, LAS unsigned char* lds, int tid, int lane, int wave, unsigned* qctr, unsigned& nxt) {
    const int sh = item / NCH, n = item - sh * NCH, b = sh / NSH, hh = sh - b * NSH;
    const bool delta = hh >= RH; const int h = delta ? hh - RH : hh;
    const int t0 = 64 * n; const size_t m0 = (size_t)b * T + t0;
    const bf16* P = (const bf16*)(a.ws + WS_PROJ); const float* GAB = (const float*)(a.ws + WS_GAB);
    bf16* GQ = (bf16*)(a.ws + WS_GQ); bf16* GK = (bf16*)(a.ws + WS_GK); bf16* GV = (bf16*)(a.ws + WS_GV); bf16* GW = (bf16*)(a.ws + WS_GW);
    const int fr = lane & 15, q4 = lane >> 4, d0 = 2 * lane;
    LAS float* GC = (LAS float*)(lds + SA_GC); LAS float* BETA = (LAS float*)(lds + SA_BETA); LAS float* MF = (LAS float*)(lds + SA_MF);
    const float lng = log1pf(-exp2f(-5.0f - (float)h));
    __syncthreads();
    if (delta) {
        const float* convw = a.in[3] + (size_t)l * 4 * 2304;
        unsigned raw[3][11]; f32x2v cw[3][4];
#pragma unroll
        for (int part = 0; part < 3; ++part) {
            const int c = part * 768 + h * HD + d0; const bf16* pg = PG(P, G_GQ + 6 * part + h) + d0;
#pragma unroll
            for (int j = 0; j < 4; ++j) cw[part][j] = *(const f32x2v*)(convw + j * 2304 + c);
#pragma unroll
            for (int j = 0; j < 11; ++j) { const int tt = t0 + 8 * wave - 3 + j;
                raw[part][j] = (tt >= 0) ? *(const unsigned*)(pg + ((long)m0 + 8 * wave - 3 + j) * HD) : 0u; }
        }
#pragma unroll
        for (int i = 0; i < 8; ++i) {
            const int rr = 8 * wave + i; const size_t m = m0 + rr;
            float o[3][2];
#pragma unroll
            for (int part = 0; part < 3; ++part) { float s0 = 0.f, s1 = 0.f;
#pragma unroll
                for (int j = 0; j < 4; ++j) { s0 += cw[part][j].x * bflo(raw[part][i + j]); s1 += cw[part][j].y * bfhi(raw[part][i + j]); }
                o[part][0] = silu_fast(s0); o[part][1] = silu_fast(s1); }
            const float qs = wave_sum(o[0][0] * o[0][0] + o[0][1] * o[0][1]), ks = wave_sum(o[1][0] * o[1][0] + o[1][1] * o[1][1]);
            const float qr = frsq(qs + RMS_EPS) * 0.08838834764831845f, kr = frsq(ks + RMS_EPS);
            const unsigned qp = pkbf(o[0][0] * qr, o[0][1] * qr), kp = pkbf(o[1][0] * kr, o[1][1] * kr), vp = pkbf(o[2][0], o[2][1]);
            *(unsigned*)(PG(GQ, h) + m * HD + d0) = qp;
            *(LAS unsigned*)(lds + SA_QB + rr * 272 + d0 * 2) = qp; *(LAS unsigned*)(lds + SA_KB + rr * 272 + d0 * 2) = kp; *(LAS unsigned*)(lds + SA_VB + rr * 272 + d0 * 2) = vp;
        }
    } else {
        unsigned rq[8], rk[8];
#pragma unroll
        for (int i = 0; i < 8; ++i) { const size_t mo = (m0 + 8 * wave + i) * HD + d0; rq[i] = *(const unsigned*)(PG(P, G_RQ + h) + mo); rk[i] = *(const unsigned*)(PG(P, G_RK + h) + mo); }
#pragma unroll
        for (int i = 0; i < 8; ++i) { const int rr = 8 * wave + i; *(LAS unsigned*)(lds + SA_QB + rr * 272 + d0 * 2) = rq[i]; *(LAS unsigned*)(lds + SA_KB + rr * 272 + d0 * 2) = rk[i]; }
    }
    if (wave == 7) {
        float g = delta ? GAB[(m0 + lane) * 12 + h] : lng;
#pragma unroll
        for (int o = 1; o < 64; o <<= 1) { const float t = __shfl_up(g, o); if (lane >= o) g += t; }
        GC[lane] = g; BETA[lane] = delta ? GAB[(m0 + lane) * 12 + 6 + h] : 1.0f;
    }
    __syncthreads();
    if (tid == 0) nxt = __hip_atomic_fetch_add(qctr, 1u, __ATOMIC_RELAXED, __HIP_MEMORY_SCOPE_AGENT);
    bf16* QKD = (bf16*)(a.ws + WS_QKD) + ((size_t)sh * NCH + n) * 4096;
    const int ntiles = delta ? 20 : 10;
    for (int p = wave; p < ntiles; p += 8) {
        const bool isqk = p < 10; const int pp = isqk ? p : p - 10;
        const int it = (pp >= 6) ? 3 : (pp >= 3) ? 2 : (pp >= 1) ? 1 : 0, jt = pp - (it * (it + 1)) / 2;
        const LAS unsigned char* Ab = lds + (isqk ? SA_QB : SA_KB) + (16 * it + fr) * 272 + q4 * 16;
        const LAS unsigned char* Bb = lds + SA_KB + (16 * jt + fr) * 272 + q4 * 16;
        f32x4 acc = {0.f, 0.f, 0.f, 0.f};
#pragma unroll
        for (int ks = 0; ks < 4; ++ks) acc = MFMA16(*(const LAS bf16x8*)(Ab + 64 * ks), *(const LAS bf16x8*)(Bb + 64 * ks), acc);
        const int j = 16 * jt + fr; const float gj = GC[j];
#pragma unroll
        for (int r = 0; r < 4; ++r) {
            const int i = 16 * it + 4 * q4 + r; const float gi = GC[i];
            const float dec = fexp(fminf(gi - gj, 0.f));
            if (isqk) { const float val = (i >= j) ? acc[r] * dec * (delta ? 1.0f : 0.08838834764831845f) : 0.f; QKD[i * 64 + j] = (bf16)(pkbf(val, 0.f) & 0xffffu); }
            else { MF[i * 68 + j] = (i > j) ? BETA[i] * acc[r] * dec : 0.f; }
        }
    }
    {
#pragma unroll
        for (int u = 0; u < 2; ++u) { const int pck = wave + 8 * u;
            const v4u kk4 = *(const LAS v4u*)(lds + SA_KB + lane * 272 + pck * 16);
            const unsigned kw[4] = {kk4.x, kk4.y, kk4.z, kk4.w};
#pragma unroll
            for (int jj = 0; jj < 8; ++jj) *(LAS unsigned short*)(lds + SA_KT + (pck * 8 + jj) * 144 + lane * 2) = (unsigned short)((jj & 1) ? (kw[jj >> 1] >> 16) : (kw[jj >> 1] & 0xffffu));
            if (delta) { const v4u vv4 = *(const LAS v4u*)(lds + SA_VB + lane * 272 + pck * 16); const unsigned vw[4] = {vv4.x, vv4.y, vv4.z, vv4.w};
#pragma unroll
                for (int jj = 0; jj < 8; ++jj) *(LAS unsigned short*)(lds + SA_VT + (pck * 8 + jj) * 144 + lane * 2) = (unsigned short)((jj & 1) ? (vw[jj >> 1] >> 16) : (vw[jj >> 1] & 0xffffu)); } }
    }
    for (int idx = tid; idx < 6 * 256; idx += NTHREADS) {
        const int u = idx >> 8, e = idx & 255; const int it = (u < 3) ? 0 : (u < 5) ? 1 : 2, jt = (u < 3) ? u + 1 : (u < 5) ? u - 1 : 3;
        QKD[(16 * it + (e >> 4)) * 64 + 16 * jt + (e & 15)] = 0;
        if (delta) MF[(16 * it + (e >> 4)) * 68 + 16 * jt + (e & 15)] = 0.f;
    }
    __syncthreads();
    {
        bf16* ktd = (delta ? PG(GK, h) : PG((bf16*)(a.ws + WS_PROJ), G_RK + h)) + m0 * HD;
#pragma unroll
        for (int u = 0; u < 2; ++u) { const int p = tid + NTHREADS * u, d = p >> 3, pc = p & 7; *(v4u*)(ktd + d * 64 + pc * 8) = *(const LAS v4u*)(lds + SA_KT + d * 144 + pc * 16); }
    }
    if (delta) {
        const int bh6 = b * GH + h;
        if (wave == 0) {
            {
                const int ab = lane >> 4, cc = lane & 15;
                LAS float* mb = MF + (16 * ab) * 68 + 16 * ab;
                float Td[16];
#pragma unroll
                for (int r = 0; r < 16; ++r) {
                    f32x4 mr[4];
#pragma unroll
                    for (int j4 = 0; j4 < (r + 3) / 4; ++j4) mr[j4] = *(const LAS f32x4*)(mb + r * 68 + 4 * j4);
                    __builtin_amdgcn_sched_barrier(0);
                    float a0 = (cc == r) ? 1.f : 0.f, a1 = 0.f;
#pragma unroll
                    for (int j = 0; j < r; ++j) { if (j & 1) a1 -= mr[j >> 2][j & 3] * Td[j]; else a0 -= mr[j >> 2][j & 3] * Td[j]; }
                    Td[r] = a0 + a1;
                    __builtin_amdgcn_sched_barrier(0);
                }
#pragma unroll
                for (int r = 0; r < 16; ++r) mb[r * 68 + cc] = Td[r];
            }
            LDS_WAIT(); asm volatile("" ::: "memory");
#pragma unroll
            for (int ar = 1; ar < 4; ++ar) {
                f32x4 Rt[3];
#pragma unroll
                for (int nb = 0; nb < ar; ++nb) {
                    f32x4 acc = {0.f, 0.f, 0.f, 0.f};
#pragma unroll
                    for (int ks = 0; ks < (ar + 1) / 2; ++ks) {
                        const int k0 = 32 * ks + 8 * q4;
                        f32x4 l0 = *(const LAS f32x4*)(MF + (16 * ar + fr) * 68 + k0), l1 = *(const LAS f32x4*)(MF + (16 * ar + fr) * 68 + k0 + 4);
                        if (k0 >= 16 * ar) { l0 = (f32x4){0.f, 0.f, 0.f, 0.f}; l1 = l0; }
                        f32x4 t0 = {MF[(k0 + 0) * 68 + 16 * nb + fr], MF[(k0 + 1) * 68 + 16 * nb + fr], MF[(k0 + 2) * 68 + 16 * nb + fr], MF[(k0 + 3) * 68 + 16 * nb + fr]};
                        f32x4 t1 = {MF[(k0 + 4) * 68 + 16 * nb + fr], MF[(k0 + 5) * 68 + 16 * nb + fr], MF[(k0 + 6) * 68 + 16 * nb + fr], MF[(k0 + 7) * 68 + 16 * nb + fr]};
                        acc = MFMA16(pack8(l0, l1), pack8(t0, t1), acc);
                    }
                    Rt[nb] = acc;
                }
                const f32x4 td = *(const LAS f32x4*)(MF + (16 * ar + fr) * 68 + 16 * ar + 4 * q4);
                const f32x4 z4 = {0.f, 0.f, 0.f, 0.f};
                const bf16x8 ta = pack8(td, z4);
#pragma unroll
                for (int nb = 0; nb < ar; ++nb) {
                    const f32x4 tn = MFMA16(ta, pack8(Rt[nb], z4), z4);
#pragma unroll
                    for (int r = 0; r < 4; ++r) MF[(16 * ar + 4 * q4 + r) * 68 + 16 * nb + fr] = -tn[r];
                }
                LDS_WAIT(); asm volatile("" ::: "memory");
            }
        } else if (wave == 1) {
            float* EGS = (float*)(a.ws + WS_EGS) + ((size_t)bh6 * T + t0 + lane) * 2;
            const float gl = GC[63], gi = GC[lane];
            EGS[0] = fexp(gi); EGS[1] = fexp(gl - gi);
            if (lane == 0) ((float*)(a.ws + WS_ALPHA))[bh6 * NCH + n] = fexp(gl);
        }
        __syncthreads();
        {
            const int row = tid >> 3, c0 = (tid & 7) * 8;
            const f32x4 t0v = *(const LAS f32x4*)(MF + row * 68 + c0), t1v = *(const LAS f32x4*)(MF + row * 68 + c0 + 4);
            const f32x4 b0 = *(const LAS f32x4*)(BETA + c0), b1 = *(const LAS f32x4*)(BETA + c0 + 4);
            const f32x4 g0 = *(const LAS f32x4*)(GC + c0), g1 = *(const LAS f32x4*)(GC + c0 + 4);
            const f32x4 x0 = t0v * b0, x1 = t1v * b1;
            const f32x4 e0v = {fexp(g0.x), fexp(g0.y), fexp(g0.z), fexp(g0.w)}, e1v = {fexp(g1.x), fexp(g1.y), fexp(g1.z), fexp(g1.w)};
            *(LAS bf16x8*)(lds + SA_TBB + row * 144 + c0 * 2) = pack8(x0, x1);
            *(LAS bf16x8*)(lds + SA_TBE + row * 144 + c0 * 2) = pack8(x0 * e0v, x1 * e1v);
        }
        __syncthreads();
#pragma unroll
        for (int which = 0; which < 2; ++which) {
            const LAS unsigned char* Ab = lds + (which ? SA_VT : SA_KT) + (16 * wave + fr) * 144 + q4 * 16;
            bf16* dst = PG(which ? GV : GW, h) + m0 * HD + 16 * wave + 4 * q4;
#pragma unroll
            for (int it = 0; it < 4; ++it) {
                const LAS unsigned char* Bb = lds + (which ? SA_TBB : SA_TBE) + (16 * it + fr) * 144 + q4 * 16;
                f32x4 acc = {0.f, 0.f, 0.f, 0.f};
#pragma unroll
                for (int ks = 0; ks < 2; ++ks) acc = MFMA16(*(const LAS bf16x8*)(Ab + 64 * ks), *(const LAS bf16x8*)(Bb + 64 * ks), acc);
                uint2 o; o.x = pkbf(acc[0], acc[1]); o.y = pkbf(acc[2], acc[3]);
                *(uint2*)(dst + (size_t)(16 * it + fr) * HD) = o;
            }
        }
    }
    __syncthreads();
}

constexpr int B_KB = 0, B_QB = 17408, B_KT = 34816, B_QD = 53248, B_V = 62464, B_EG = 71680, B_BUF = 72704;
constexpr int B_END = QW_OFF;
#define SCHED_FENCE() __builtin_amdgcn_sched_barrier(0)
template <bool DELTA, bool FULL>
__device__ __forceinline__ void sb_chunk(f32x4 (&S)[8], const LAS unsigned char* lds, const LAS unsigned char* a272, const LAS unsigned char* a144, const LAS unsigned char* vcol, const LAS float* EG, int q4, bf16* ybase) {
    constexpr bool delta = DELTA;
        {
        bf16x8 Sb[4];
#pragma unroll
        for (int s = 0; s < 4; ++s) Sb[s] = pack8(S[2 * s], S[2 * s + 1]);
        bf16x8 fk[4], fq[4], gk[4], gq[4];
        unsigned short vr[16]; f32x4 egv[4];
#pragma unroll
        for (int it = 0; it < 4; ++it) { egv[it] = *(const LAS f32x4*)(EG + 16 * it + 4 * q4);
#pragma unroll
            for (int r = 0; r < 4; ++r) vr[4 * it + r] = *(const LAS unsigned short*)(vcol + (16 * it + r) * 144); }
#pragma unroll
        for (int s = 0; s < 4; ++s) { if (delta) fk[s] = ldA2(a272 + B_KB + 64 * s); if (FULL) fq[s] = ldA2(a272 + B_QB + 64 * s); }
        SCHED_FENCE();
        f32x4 R[4], qs[4];
#define SB_KQ(it, FK, FQ, NK, NQ) do { \
            if ((it) < 3) { _Pragma("unroll") for (int s = 0; s < 4; ++s) { if (delta) NK[s] = ldA2(a272 + B_KB + (16 * ((it) + 1)) * 272 + 64 * s); if (FULL) NQ[s] = ldA2(a272 + B_QB + (16 * ((it) + 1)) * 272 + 64 * s); } } \
            f32x4 ks = {0.f, 0.f, 0.f, 0.f}; qs[it] = (f32x4){0.f, 0.f, 0.f, 0.f}; \
            _Pragma("unroll") for (int s = 0; s < 4; ++s) { if (delta) ks = MFMA16(FK[s], Sb[s], ks); if (FULL) qs[it] = MFMA16(FQ[s], Sb[s], qs[it]); } \
            _Pragma("unroll") for (int r = 0; r < 4; ++r) { const float v = bf2f(vr[4 * (it) + r]); R[it][r] = delta ? v - ks[r] : v; } \
            qs[it] = qs[it] * egv[it]; \
            SCHED_FENCE(); } while (0)
        SB_KQ(0, fk, fq, gk, gq); SB_KQ(1, gk, gq, fk, fq); SB_KQ(2, fk, fq, gk, gq);
        bf16x8 fd[8];
#pragma unroll
        for (int i = 0; i < 8; ++i) { if (FULL) fd[i] = ldA2(a144 + B_QD + (16 * (i >> 1)) * 144 + 64 * (i & 1)); }
        SB_KQ(3, gk, gq, fk, fq);
#undef SB_KQ
        bf16x8 Rb[2];
#pragma unroll
        for (int s = 0; s < 2; ++s) Rb[s] = pack8(R[2 * s], R[2 * s + 1]);
        f32x4 vn[4]; bf16x8 VNb[2];
#pragma unroll
        for (int it = 0; it < 4; ++it) vn[it] = R[it];
        VNb[0] = Rb[0]; VNb[1] = Rb[1];
        bf16x8 VSb[2];
#pragma unroll
        for (int s = 0; s < 2; ++s) { const f32x4 g0 = *(const LAS f32x4*)(EG + 64 + 32 * s + 4 * q4), g1 = *(const LAS f32x4*)(EG + 64 + 32 * s + 16 + 4 * q4); VSb[s] = pack8(g0 * vn[2 * s], g1 * vn[2 * s + 1]); }
        const float alpha = EG[128];
        bf16x8 fs[8];
#pragma unroll
        for (int i = 0; i < 8; ++i) fs[i] = ldA2(a144 + B_KT + (16 * (i >> 1)) * 144 + 64 * (i & 1));
        if (FULL) {
#pragma unroll
        for (int it = 0; it < 4; ++it) { f32x4 o = qs[it];
#pragma unroll
            for (int s = 0; s < 2; ++s) o = MFMA16(fd[2 * it + s], VNb[s], o);
            bf16* yp = ybase + (size_t)(16 * it) * DM;
            const unsigned o01 = pkbf(o[0], o[1]), o23 = pkbf(o[2], o[3]);
            yp[0] = (bf16)(o01 & 0xffffu); yp[DM] = (bf16)(o01 >> 16); yp[2 * DM] = (bf16)(o23 & 0xffffu); yp[3 * DM] = (bf16)(o23 >> 16); }
        }
        SCHED_FENCE();
        bf16x8 fs2[8];
#pragma unroll
        for (int i = 0; i < 8; ++i) fs2[i] = ldA2(a144 + B_KT + (16 * (4 + (i >> 1))) * 144 + 64 * (i & 1));
#pragma unroll
        for (int dt = 0; dt < 4; ++dt) { S[dt] = S[dt] * alpha;
#pragma unroll
            for (int s = 0; s < 2; ++s) S[dt] = MFMA16(fs[2 * dt + s], VSb[s], S[dt]); }
        SCHED_FENCE();
#pragma unroll
        for (int dt = 4; dt < 8; ++dt) { S[dt] = S[dt] * alpha;
#pragma unroll
            for (int s = 0; s < 2; ++s) S[dt] = MFMA16(fs2[2 * (dt - 4) + s], VSb[s], S[dt]); }
        }
}
#undef SCHED_FENCE

template <bool DELTA>
__device__ __forceinline__ void sb_item(const Args& a, int l, int sh, int half, int nfull, int nend, LAS unsigned char* lds, int tid, int lane, int wave) {
    const int b = sh / NSH, hh = sh - b * NSH; constexpr bool delta = DELTA; const int h = delta ? hh - RH : hh, bh6 = b * GH + h;
    const bf16* P = (const bf16*)(a.ws + WS_PROJ); bf16* Y = (bf16*)(a.ws + WS_Y);
    const bf16* qg = delta ? PG((const bf16*)(a.ws + WS_GQ), h) : PG(P, G_RQ + h);
    const bf16* kg = delta ? PG((const bf16*)(a.ws + WS_GK), h) : PG(P, G_RK + h);
    const bf16* vg = delta ? PG((const bf16*)(a.ws + WS_GV), h) : PG(P, G_RV + h);
    constexpr size_t ld = HD; const size_t m0 = (size_t)b * T;
    const bf16* wg = PG((const bf16*)(a.ws + WS_GW), h); const bf16* QDp = (const bf16*)(a.ws + WS_QKD) + (size_t)sh * NCH * 4096;
    const float* EGS = (const float*)(a.ws + WS_EGS) + (size_t)bh6 * T * 2; const float* ALPHA = (const float*)(a.ws + WS_ALPHA) + bh6 * NCH;
    const int gcol = delta ? C_GZ + h * HD : C_RG + h * HD, ycol = delta ? 512 + h * HD : h * HD;
    const float* nw = delta ? a.in[7] + (size_t)l * HD : a.in[6] + ((size_t)l * RH + h) * HD;
    const int fr = lane & 15, q4 = lane >> 4, e0 = 64 * half + 16 * (wave & 3);
    const bool cw = wave < 4;
    struct PF { v4u pk[4], pw[4], pq[4], pv[2], pd[2]; float peg; };
    PF fa, fb;
    const int ht = tid - 256, hw = wave - 4;
#define SB_LOAD(F, nn) do { \
        _Pragma("unroll") for (int u = 0; u < 4; ++u) { \
            F.pk[u] = *(const v4u*)(kg + (m0 + 64 * (nn)) * ld + (ht + 256 * u) * 8); \
            const int p = ht + 256 * u, row = p >> 4, pc = p & 15; \
            F.pq[u] = *(const v4u*)(qg + (m0 + 64 * (nn) + row) * ld + pc * 8); \
            if (delta) F.pw[u] = *(const v4u*)(wg + (m0 + 64 * (nn) + row) * ld + pc * 8); } \
        _Pragma("unroll") for (int u = 0; u < 2; ++u) { const int p = ht + 256 * u; const size_t off = (size_t)(nn) * 4096 + (p >> 3) * 64 + (p & 7) * 8; F.pd[u] = *(const v4u*)(QDp + off); \
            F.pv[u] = *(const v4u*)(vg + (m0 + 64 * (nn) + (p >> 3)) * ld + 64 * half + (p & 7) * 8); } \
        if (delta) { const float* pp = (ht < 128) ? EGS + (64 * (nn) + (ht & 63)) * 2 + (ht >> 6) : ALPHA + (nn); F.peg = *pp; } \
    } while (0)
#define SB_STORE(F, BO, WQ) do {        \
        _Pragma("unroll") for (int u = 0; u < 4; ++u) { \
            const int p = ht + 256 * u, row = p >> 4, pc = p & 15; \
            *(LAS v4u*)(lds + (BO) + B_KT + (p >> 3) * 144 + (p & 7) * 16) = F.pk[u]; \
            if (delta) *(LAS v4u*)(lds + (BO) + B_KB + row * 272 + pc * 16) = F.pw[u]; } \
        _Pragma("unroll") for (int u = 0; u < 2; ++u) { const int p = ht + 256 * u, row = p >> 3, pc = p & 7; *(LAS v4u*)(lds + (BO) + B_V + row * 144 + pc * 16) = F.pv[u]; } \
        if (WQ) { \
            _Pragma("unroll") for (int u = 0; u < 4; ++u) { const int p = ht + 256 * u, row = p >> 4, pc = p & 15; *(LAS v4u*)(lds + (BO) + B_QB + row * 272 + pc * 16) = F.pq[u]; } \
            _Pragma("unroll") for (int u = 0; u < 2; ++u) { const int p = ht + 256 * u, row = p >> 3, pc = p & 7; *(LAS v4u*)(lds + (BO) + B_QD + row * 144 + pc * 16) = F.pd[u]; } } \
        if (delta && ht < 129) ((LAS float*)(lds + (BO) + B_EG))[ht] = F.peg; \
    } while (0)
    __syncthreads();
    if (!delta) {
        const float lng = log1pf(-exp2f(-5.0f - (float)h));
        float ev = 0.f;
        if (tid < 64) ev = expf((float)(tid + 1) * lng);
        else if (tid < 128) ev = 0.08838834764831845f * expf((float)(127 - tid) * lng);
        else if (tid == 128) ev = expf(64.f * lng);
        if (tid < 129) { ((LAS float*)(lds + B_EG))[tid] = ev; ((LAS float*)(lds + B_BUF + B_EG))[tid] = ev; }
    }
    if (!cw) { SB_LOAD(fa, 0); SB_STORE(fa, 0, nfull == 0); SB_LOAD(fa, 1); { const int nl = (2 < nend) ? 2 : nend - 1; SB_LOAD(fb, nl); } }
    __syncthreads();
    f32x4 S[8];
#pragma unroll
    for (int dt = 0; dt < 8; ++dt) S[dt] = (f32x4){0.f, 0.f, 0.f, 0.f};
    const int o272 = fr * 272 + 8 * q4, o144 = fr * 144 + 8 * q4, ovc = B_V + (4 * q4) * 144 + (16 * (wave & 3) + fr) * 2;
#define SCHED_FENCE() __builtin_amdgcn_sched_barrier(0)
    if (!cw) {
#pragma unroll 1
        for (int n2 = 0; n2 < nend; n2 += 2) {
            SB_STORE(fa, B_BUF, n2 + 1 >= nfull);
            { const int nl = (n2 + 3 < nend) ? n2 + 3 : nend - 1; SB_LOAD(fa, nl); }
            __syncthreads();
            SB_STORE(fb, 0, n2 + 2 >= nfull);
            { const int nl = (n2 + 4 < nend) ? n2 + 4 : nend - 1; SB_LOAD(fb, nl); }
            __syncthreads();
        }
    } else {
    bf16* yb0 = Y + (m0 + 4 * q4) * DM + ycol + e0 + fr;
#pragma unroll 1
    for (int n = 0; n < nfull; ++n) {
        const LAS unsigned char* bb = lds + (n & 1) * B_BUF;
        sb_chunk<DELTA, false>(S, lds, bb + o272, bb + o144, bb + ovc, (const LAS float*)(bb + B_EG), q4, yb0);
        __syncthreads();
    }
#pragma unroll 1
    for (int n = nfull; n < nend; ++n) {
        const LAS unsigned char* bb = lds + (n & 1) * B_BUF;
        sb_chunk<DELTA, true>(S, lds, bb + o272, bb + o144, bb + ovc, (const LAS float*)(bb + B_EG), q4, yb0 + (size_t)(64 * n) * DM);
        __syncthreads();
    }
    }
#undef SCHED_FENCE
#undef SB_LOAD
#undef SB_STORE
}
__device__ __forceinline__ void fx_rows(const Args& a, int l, int gw, int NGW, int lane) {
    const bf16* P = (const bf16*)(a.ws + WS_PROJ); bf16* Y = (bf16*)(a.ws + WS_Y);
    const float* rnw = a.in[6] + (size_t)l * RH * HD; const float* gnw = a.in[7] + (size_t)l * HD;
    const int d0 = 2 * lane;
    f32x2v wr[RH];
#pragma unroll
    for (int h = 0; h < RH; ++h) wr[h] = *(const f32x2v*)(rnw + h * HD + d0);
    const f32x2v wg = *(const f32x2v*)(gnw + d0);
    for (int m = gw; m < M; m += NGW) {
        unsigned ou[NSH], zu[NSH];
#pragma unroll
        for (int hh = 0; hh < NSH; ++hh) { ou[hh] = *(const unsigned*)(Y + (size_t)m * DM + hh * HD + d0);
            zu[hh] = *(const unsigned*)(PG(P, (hh < RH) ? (G_RG + hh) : (G_GZ + hh - RH)) + (size_t)m * HD + d0); }
#pragma unroll
        for (int hh = 0; hh < NSH; ++hh) {
            const float ox = bflo(ou[hh]), oy = bfhi(ou[hh]);
            const float rs = __builtin_amdgcn_rsqf(wave_sum(ox * ox + oy * oy) * (1.f / HD) + RMS_EPS);
            const f32x2v w = (hh < RH) ? wr[hh < RH ? hh : 0] : wg;
            *(unsigned*)(Y + (size_t)m * DM + hh * HD + d0) = pkbf(ox * rs * w.x * silu_fast(bflo(zu[hh])), oy * rs * w.y * silu_fast(bfhi(zu[hh])));
        }
    }
}

typedef float f32x16 __attribute__((ext_vector_type(16)));
#define MFMA32(a, b, c) __builtin_amdgcn_mfma_f32_32x32x16_bf16((a), (b), (c), 0, 0, 0)
constexpr int MB_KM = 0, MB_K0 = 16384, MB_V0 = 49152, MB_VSZ = 17408, MB_TL = 83968, MB_UN = 84480, MB_END = 84608;
constexpr int MB_ENTRIES = 224, MB_ITEMS = BATCH * MB_ENTRIES, MB_SLOTS = 32;
__device__ const unsigned short mb_order[MB_ENTRIES] = {32509, 32765, 124, 125, 30453, 30709, 28397, 28653, 116, 117, 31484, 31740, 29428, 29684, 27372, 27628, 25316, 25572, 26341, 26597, 23260, 23516, 24285, 24541, 108, 109, 21204, 21460, 22229, 22485, 19148, 19404, 20173, 20429, 100, 101, 17092, 17348, 18117, 18373, 251, 243, 235, 227, 219, 211, 203, 195, 187, 15036, 15292, 16061, 16317, 179, 171, 163, 155, 147, 139, 131, 123, 115, 107, 99, 91, 92, 93, 12980, 13236, 14005, 14261, 10924, 11180, 11949, 12205, 83, 84, 85, 8868, 9124, 9893, 10149, 6812, 7068, 7837, 8093, 75, 76, 77, 4756, 5012, 5781, 6037, 2700, 2956, 3725, 3981, 67, 68, 69, 644, 900, 1669, 1925, 59, 60, 61, 51, 52, 53, 250, 242, 234, 226, 218, 210, 202, 194, 186, 178, 170, 162, 154, 146, 138, 130, 122, 114, 106, 98, 90, 82, 74, 66, 58, 50, 42, 43, 44, 45, 34, 35, 36, 37, 26, 27, 28, 29, 249, 241, 233, 225, 217, 209, 201, 193, 185, 177, 169, 161, 153, 145, 137, 129, 121, 113, 105, 97, 89, 81, 73, 65, 57, 49, 41, 33, 25, 17, 18, 19, 20, 21, 248, 240, 232, 224, 216, 208, 200, 192, 184, 176, 168, 160, 152, 144, 136, 128, 120, 112, 104, 96, 88, 80, 72, 64, 56, 48, 40, 32, 24, 16, 8, 9, 10, 11, 12, 13, 0, 1, 2, 3, 4, 5};
constexpr size_t WS_MBP = 482 * MiB;
__device__ __forceinline__ void mb_item(const Args& a, int l, int item, LAS unsigned char* lds, int tid, int lane, int wave) {
    const int oe = (int)mb_order[item >> 1], qb = (oe >> 3) & 31, h = oe & 7, piece = (oe >> 8) & 1, npieces = ((oe >> 9) & 1) + 1, slot = (oe >> 10) + MB_SLOTS * (item & 1), b = item & 1, bh = b * MH + h, own = qb;
    const bf16* P = (const bf16*)(a.ws + WS_PROJ); bf16* Y = (bf16*)(a.ws + WS_Y);
    const int ql = lane & 31, hh = lane >> 5;
    const int tq0 = MOBA_BLK * qb, tq = tq0 + 32 * wave + ql;
    const size_t mrow = (size_t)b * T + tq;
    const float NEG = -__builtin_inff();
    const float c2v = exp2f(-8.0f * (float)(h + 1) / (float)MH) * 1.4426950408889634f;
    const float c2 = __builtin_bit_cast(float, __builtin_amdgcn_readfirstlane(__builtin_bit_cast(int, c2v)));
    const int reach = (int)((100.0f / c2 - 1.0f) * (1.0f / MOBA_BLK)) + 1;
    bf16x8 Qf[8];
#pragma unroll
    for (int ks = 0; ks < 8; ++ks) Qf[ks] = *(const bf16x8*)(PG(P, G_MQ + h) + mrow * HD + 16 * ks + 8 * hh);
    __syncthreads();
    { const float* KM = (const float*)(a.ws + WS_KMEAN) + (size_t)bh * MOBA_NB * HD; LAS float* km = (LAS float*)(lds + MB_KM);
      for (int i = tid; i < MOBA_NB * HD / 4; i += NTHREADS) ((LAS f32x4*)km)[i] = ((const f32x4*)KM)[i]; }
    __syncthreads();
    unsigned selmask = 0u;
    {
        float qf[64];
#pragma unroll
        for (int ks = 0; ks < 8; ++ks) { const v4u u = __builtin_bit_cast(v4u, Qf[ks]);
            qf[8 * ks] = bflo(u.x); qf[8 * ks + 1] = bfhi(u.x); qf[8 * ks + 2] = bflo(u.y); qf[8 * ks + 3] = bfhi(u.y); qf[8 * ks + 4] = bflo(u.z); qf[8 * ks + 5] = bfhi(u.z); qf[8 * ks + 6] = bflo(u.w); qf[8 * ks + 7] = bfhi(u.w); }
        float v1 = NEG, v2 = NEG, v3 = NEG; int i1 = 0, i2 = 0, i3 = 0;
#pragma unroll 1
        for (int n = 0; n < own; ++n) {
            const LAS float* kr = (const LAS float*)(lds + MB_KM) + n * HD + 8 * hh;
            float g0 = 0.f, g1 = 0.f;
#pragma unroll
            for (int ks = 0; ks < 8; ++ks) { const f32x4 ka = *(const LAS f32x4*)(kr + 16 * ks), kb = *(const LAS f32x4*)(kr + 16 * ks + 4);
                g0 += (qf[8 * ks] * ka.x + qf[8 * ks + 1] * ka.y) + (qf[8 * ks + 2] * ka.z + qf[8 * ks + 3] * ka.w);
                g1 += (qf[8 * ks + 4] * kb.x + qf[8 * ks + 5] * kb.y) + (qf[8 * ks + 6] * kb.z + qf[8 * ks + 7] * kb.w); }
            float g = g0 + g1; g += __shfl_xor(g, 32);
            if (g > v1) { v3 = v2; i3 = i2; v2 = v1; i2 = i1; v1 = g; i1 = n; }
            else if (g > v2) { v3 = v2; i3 = i2; v2 = g; i2 = n; }
            else if (g > v3) { v3 = g; i3 = n; }
        }
        if (v1 > NEG) selmask |= 1u << i1;
        if (v2 > NEG) selmask |= 1u << i2;
        if (v3 > NEG) selmask |= 1u << i3;
    }
    {
        unsigned u = selmask;
#pragma unroll
        for (int o = 1; o < 64; o <<= 1) u |= __shfl_xor(u, o);
        if (lane == 0) ((LAS unsigned*)(lds + MB_UN))[wave] = u;
        __syncthreads();
        if (tid == 0) {
            unsigned un = 0u;
            for (int w = 0; w < NWAVES; ++w) un |= ((LAS unsigned*)(lds + MB_UN))[w];
            LAS unsigned short* tl = (LAS unsigned short*)(lds + MB_TL); int cnt = 0;
            for (int kt = 0; kt < 4; ++kt) tl[cnt++] = (unsigned short)(own * MOBA_BLK + 64 * kt);
            for (int j = own - 1; j >= 0 && own - j <= reach; --j) if ((un >> j) & 1u) for (int kt = 0; kt < 4; ++kt) tl[cnt++] = (unsigned short)(j * MOBA_BLK + 64 * kt);
            ((LAS unsigned*)(lds + MB_UN))[8] = (unsigned)cnt;
        }
        __syncthreads();
    }
    const int ntiles_all = (int)((LAS unsigned*)(lds + MB_UN))[8];
    const int tper = (ntiles_all + npieces - 1) / npieces, t_lo = piece * tper, ntiles = min(ntiles_all, t_lo + tper);
    const LAS unsigned short* tl = (const LAS unsigned short*)(lds + MB_TL);
    const bf16* kbase = PG(P, G_MK + h) + (size_t)b * T * HD; const bf16* vbase = PG(P, G_MV + h) + (size_t)b * T * HD;
    v4u pvv[2];
#define MB_LOAD(kp0, bufn) do { _Pragma("unroll") for (int u = 0; u < 2; ++u) { const int p = tid + NTHREADS * u, row = p >> 4, sl = p & 15; \
        __builtin_amdgcn_global_load_lds((const unsigned*)(kbase + (size_t)((kp0) + row) * HD + ((sl ^ (row & 15)) * 8)), (LAS unsigned*)(lds + MB_K0 + (bufn) * 16384 + wave * 1024 + u * 8192), 16, 0, 0); \
        pvv[u] = *(const v4u*)(vbase + (size_t)((kp0) + lane) * HD + (wave + 8 * u) * 8); } } while (0)
#define MB_STORE(buf) do { _Pragma("unroll") for (int u = 0; u < 2; ++u) { \
        const unsigned w4[4] = {pvv[u].x, pvv[u].y, pvv[u].z, pvv[u].w}; const int pcv = wave + 8 * u; \
        _Pragma("unroll") for (int jj = 0; jj < 8; ++jj) *(LAS unsigned short*)(lds + MB_V0 + (buf) * MB_VSZ + (pcv * 8 + jj) * 136 + lane * 2) = (unsigned short)((jj & 1) ? (w4[jj >> 1] >> 16) : (w4[jj >> 1] & 0xffffu)); } } while (0)
    if (t_lo < ntiles) { MB_LOAD((int)tl[t_lo], t_lo & 1); MB_STORE(t_lo & 1); }
    asm volatile("s_waitcnt vmcnt(0)" ::: "memory");
    __syncthreads();
    const f32x2v cA = {0.f, c2}, cB = {2.f * c2, 3.f * c2};
    f32x16 O[4];
#pragma unroll
    for (int et = 0; et < 4; ++et)
#pragma unroll
        for (int r = 0; r < 16; ++r) O[et][r] = 0.f;
    asm volatile("" :: "v"(Qf[0]), "v"(Qf[1]), "v"(Qf[2]), "v"(Qf[3]), "v"(Qf[4]), "v"(Qf[5]), "v"(Qf[6]), "v"(Qf[7]));
    float mrun = -1e30f, lsum = 0.f;
#pragma unroll 1
    for (int ti = t_lo; ti < ntiles; ++ti) {
        const int kp0 = (int)tl[ti], buf = ti & 1;
        { const int tn = (ti + 1 < ntiles) ? ti + 1 : ti; MB_LOAD((int)tl[tn], buf ^ 1); }
        const int blk = kp0 >> 8; const bool isown = (blk == own);
        const bool rowact = isown ? true : (((selmask >> blk) & 1u) != 0u);
        const bool wave_on = isown ? (kp0 <= tq0 + 32 * wave + 31) : (__ballot(rowact) != 0ull);
        if (wave_on) {
            const float moff = (mrun < -1e29f) ? 0.f : mrun;
            f32x16 sc[2];
#pragma unroll
            for (int sub = 0; sub < 2; ++sub) {
#pragma unroll
                for (int r = 0; r < 16; ++r) sc[sub][r] = 0.f;
                const int row = 32 * sub + ql; const LAS unsigned char* kb = lds + MB_K0 + buf * 16384 + row * 256;
#pragma unroll
                for (int ks = 0; ks < 8; ++ks) sc[sub] = MFMA32(*(const LAS bf16x8*)(kb + (((2 * ks + hh) ^ (row & 15)) << 4)), Qf[ks], sc[sub]);
            }
            float mt = NEG;
#pragma unroll
            for (int sub = 0; sub < 2; ++sub) {
                const int kb0 = kp0 + 32 * sub + 4 * hh; const float binit = rowact ? c2 * (float)(kb0 - tq0) - moff : NEG;
#pragma unroll
                for (int j = 0; j < 4; ++j) {
                    const float aj = c2 * (float)(8 * j) + binit; const f32x2v a2 = {aj, aj};
                    f32x2v v01 = (f32x2v){sc[sub][4 * j], sc[sub][4 * j + 1]} + (a2 + cA), v23 = (f32x2v){sc[sub][4 * j + 2], sc[sub][4 * j + 3]} + (a2 + cB);
                    if (isown) { const int kk0 = kb0 + 8 * j; v01.x = (kk0 <= tq) ? v01.x : NEG; v01.y = (kk0 + 1 <= tq) ? v01.y : NEG; v23.x = (kk0 + 2 <= tq) ? v23.x : NEG; v23.y = (kk0 + 3 <= tq) ? v23.y : NEG; }
                    sc[sub][4 * j] = v01.x; sc[sub][4 * j + 1] = v01.y; sc[sub][4 * j + 2] = v23.x; sc[sub][4 * j + 3] = v23.y;
                    mt = fmaxf(mt, v01.x); mt = fmaxf(mt, v01.y); mt = fmaxf(mt, v23.x); mt = fmaxf(mt, v23.y); }
            }
            mt = fmaxf(mt, __shfl_xor(mt, 32));
            if (__any(mt + moff > mrun + 6.0f)) {
                const float mnew = fmaxf(mrun, mt + moff), alpha = __builtin_amdgcn_exp2f(mrun - mnew), dlt = mnew - moff;
#pragma unroll
                for (int et = 0; et < 4; ++et) O[et] = O[et] * alpha;
                lsum *= alpha; mrun = mnew;
#pragma unroll
                for (int sub = 0; sub < 2; ++sub) sc[sub] = sc[sub] - dlt; }
            {   f32x2v pa = {0.f, 0.f}, pb = {0.f, 0.f};
#pragma unroll
                for (int r = 0; r < 16; r += 2) { const float p0 = __builtin_amdgcn_exp2f(sc[0][r]), p1 = __builtin_amdgcn_exp2f(sc[0][r + 1]), p2 = __builtin_amdgcn_exp2f(sc[1][r]), p3 = __builtin_amdgcn_exp2f(sc[1][r + 1]);
                    sc[0][r] = p0; sc[0][r + 1] = p1; sc[1][r] = p2; sc[1][r + 1] = p3; pa += (f32x2v){p0, p1}; pb += (f32x2v){p2, p3}; }
                pa += pb; lsum += pa.x + pa.y; }
            bf16x8 Pb[4];
#pragma unroll
            for (int kk = 0; kk < 4; ++kk) { const int sub = kk >> 1, s2 = kk & 1; v4u pp;
                pp.x = pkbf(sc[sub][8 * s2], sc[sub][8 * s2 + 1]); pp.y = pkbf(sc[sub][8 * s2 + 2], sc[sub][8 * s2 + 3]); pp.z = pkbf(sc[sub][8 * s2 + 4], sc[sub][8 * s2 + 5]); pp.w = pkbf(sc[sub][8 * s2 + 6], sc[sub][8 * s2 + 7]);
                Pb[kk] = __builtin_bit_cast(bf16x8, pp); }
#pragma unroll
            for (int et = 0; et < 4; ++et) { const LAS unsigned char* vb = lds + MB_V0 + buf * MB_VSZ + (32 * et + ql) * 136 + 8 * hh;
#pragma unroll
                for (int kk = 0; kk < 4; ++kk) { const s16x4 lo = *(const volatile LAS s16x4*)(vb + 32 * kk), hi = *(const volatile LAS s16x4*)(vb + 32 * kk + 16);
                    O[et] = MFMA32(__builtin_shufflevector(lo, hi, 0, 1, 2, 3, 4, 5, 6, 7), Pb[kk], O[et]); } }
        }
        if (ti + 1 < ntiles) MB_STORE(buf ^ 1);
        asm volatile("s_waitcnt vmcnt(0)" ::: "memory");
        __syncthreads();
    }
#undef MB_LOAD
#undef MB_STORE
    if (npieces > 1) {
        float* part = (float*)(a.ws + WS_MBP) + (size_t)(slot * 2) * 66 * NTHREADS;
        float* mine = part + (size_t)piece * 66 * NTHREADS + tid;
#pragma unroll
        for (int et = 0; et < 4; ++et)
#pragma unroll
            for (int r = 0; r < 16; ++r) mine[(size_t)(16 * et + r) * NTHREADS] = O[et][r];
        mine[(size_t)64 * NTHREADS] = mrun; mine[(size_t)65 * NTHREADS] = lsum;
        asm volatile("s_waitcnt vmcnt(0)" ::: "memory");
        __syncthreads();
        if (tid == 0) {
            __builtin_amdgcn_fence(__ATOMIC_RELEASE, "agent");
            asm volatile("s_waitcnt vmcnt(0)" ::: "memory");
            const unsigned old = __hip_atomic_fetch_add((unsigned*)(a.ws + WS_CTL) + CW_MBCNT + 128 * l + slot, 1u, __ATOMIC_RELAXED, __HIP_MEMORY_SCOPE_AGENT);
            if (old == (unsigned)(npieces - 1)) { __builtin_amdgcn_fence(__ATOMIC_ACQUIRE, "agent"); asm volatile("s_waitcnt vmcnt(0)" ::: "memory"); }
            ((LAS unsigned*)(lds + MB_UN))[9] = old;
        }
        __syncthreads();
        if (((LAS unsigned*)(lds + MB_UN))[9] != (unsigned)(npieces - 1)) return;
        const float* oth = part + (size_t)(piece ^ 1) * 66 * NTHREADS + tid;
        const float mo = oth[(size_t)64 * NTHREADS], lo = oth[(size_t)65 * NTHREADS];
        const float mm = fmaxf(mrun, mo), fa = __builtin_amdgcn_exp2f(mrun - mm), fb = __builtin_amdgcn_exp2f(mo - mm);
        lsum = lsum * fa + lo * fb;
#pragma unroll
        for (int et = 0; et < 4; ++et) { float ot[16];
#pragma unroll
            for (int r = 0; r < 16; ++r) ot[r] = oth[(size_t)(16 * et + r) * NTHREADS];
#pragma unroll
            for (int r = 0; r < 16; ++r) O[et][r] = O[et][r] * fa + ot[r] * fb; }
    }
    lsum += __shfl_xor(lsum, 32);
    const float inv = 1.0f / lsum;
    uint2 zall[16];
#pragma unroll
    for (int i = 0; i < 16; ++i) zall[i] = *(const uint2*)(PG(P, G_MZ + h) + mrow * HD + 32 * (i >> 2) + 8 * (i & 3) + 4 * hh);
#pragma unroll
    for (int et = 0; et < 4; ++et)
#pragma unroll
        for (int g = 0; g < 4; ++g) { const int e = 32 * et + 8 * g + 4 * hh;
            const uint2 zu = zall[4 * et + g];
            uint2 yo; yo.x = pkbf(O[et][4 * g] * inv * silu_fast(bflo(zu.x)), O[et][4 * g + 1] * inv * silu_fast(bfhi(zu.x)));
            yo.y = pkbf(O[et][4 * g + 2] * inv * silu_fast(bflo(zu.y)), O[et][4 * g + 3] * inv * silu_fast(bfhi(zu.y)));
            *(uint2*)(Y + mrow * DM + 1280 + h * HD + e) = yo; }
}
constexpr int PH_PER_LAYER = 6, N_PHASES = DEPTH * PH_PER_LAYER;
__global__ void __launch_bounds__(NTHREADS, 2) hymba_fwd(Args args) {
    extern __shared__ __attribute__((aligned(16))) unsigned char lds_raw[];
    LAS unsigned char* lds = (LAS unsigned char*)lds_raw;
    {   const int tid0 = threadIdx.x;
        for (int u = tid0; u < (LDS_BYTES - LDSCTL_OFF) / 4; u += NTHREADS) ((LAS unsigned*)(lds + LDSCTL_OFF))[u] = 0u; }
    __syncthreads();
    XcdBarrier bar = xcd_barrier_post((unsigned*)(args.ws + WS_CTL) + CW_BAR, (volatile LAS unsigned*)(lds + MISC_OFF) + 8);
    const int lo = args.ph_lo, hi = args.ph_hi;
#ifndef DUP_PHASE
#define DUP_PHASE -1
#endif
    int dup_done = 0;
#pragma unroll 1
    for (int ph = lo; ph < hi; ++ph) {
        const int l = ph / PH_PER_LAYER, k = ph - l * PH_PER_LAYER;
        Args A = args;
{ size_t zoff = 0; asm volatile("" : "+s"(zoff)); A.ws = args.ws + zoff; A.out = args.out + zoff; }
        int tid = threadIdx.x; asm volatile("" : "+v"(tid));
        const int lane = tid & 63, wave = __builtin_amdgcn_readfirstlane(tid >> 6);
        const int G = gridDim.x; int bx = blockIdx.x; asm volatile("" : "+s"(bx));
        const int vcu = (G % 8 == 0) ? (bx % 8) * (G / 8) + bx / 8 : bx;
        const int gw = vcu * NWAVES + wave, NGW = G * NWAVES;
        const float* xin = (l == 0) ? A.in[0] : A.out;
        switch (k) {
        case 0: { p0_weights(A, l, lds, gw, NGW, wave, lane); p0_rows(A, l, xin, lds, gw, NGW, tid, lane); } break;
        case 1: {
            pg8::Gemm g{(const bf16*)(A.ws + WS_H), (const bf16*)(A.ws + WS_WIN), M, NP, DM}; pg8::StaticOrder S; S.init(M, NP, G, bx);
            pg8::EpiBf16 E{(bf16*)(A.ws + WS_PROJ), 0, 0u};
            pg8::gemm_phase<pg8::EpiBf16, pg8::StaticOrder, true, true>(lds + RING_OFF, g, S, E, tid);
        } break;
        case 2: {
            unsigned* qctr = (unsigned*)(A.ws + WS_CTL) + CW_QUEUE + 64 * l + 16 + 1024 * dup_done;
            __syncthreads();
            if (tid == 0) ((LAS unsigned*)(lds + B_END))[0] = __hip_atomic_fetch_add(qctr, 1u, __ATOMIC_RELAXED, __HIP_MEMORY_SCOPE_AGENT);
            __syncthreads();
            int item = (int)((LAS unsigned*)(lds + B_END))[0];
#pragma unroll 1
            while (item < BATCH * MOBA_NB + BATCH * NSH * NCH) {
                int t2 = threadIdx.x; asm volatile("" : "+v"(t2));
                const int lane2 = t2 & 63, wave2 = __builtin_amdgcn_readfirstlane(t2 >> 6);
                unsigned nxt = 0u;
                if (item < BATCH * MOBA_NB) { mp_item(A, l, item, lds, t2, lane2, wave2); if (t2 == 0) nxt = __hip_atomic_fetch_add(qctr, 1u, __ATOMIC_RELAXED, __HIP_MEMORY_SCOPE_AGENT); }
                else sa_item(A, l, item - BATCH * MOBA_NB, lds, t2, lane2, wave2, qctr, nxt);
                if (t2 == 0) ((LAS unsigned*)(lds + B_END))[0] = nxt;
                __syncthreads();
                item = (int)((LAS unsigned*)(lds + B_END))[0];
            }
        } break;
        case 3: {
            if (bx < 4 * BATCH * GH) {
                const int di = bx >> 2, sh = (di / GH) * NSH + RH + di % GH, seg = (bx >> 1) & 1, nfull = seg ? SB_SPLIT : 0, nend = seg ? NCH : SB_SPLIT;
                sb_item<true>(A, l, sh, bx & 1, nfull, nend, lds, tid, lane, wave);
            } else if (bx < 4 * BATCH * GH + 2 * BATCH * RH) {
                const int ri = (bx - 4 * BATCH * GH) >> 1, sh = (ri / RH) * NSH + ri % RH;
                sb_item<false>(A, l, sh, bx & 1, 0, NCH, lds, tid, lane, wave); }
            unsigned* qctr = (unsigned*)(A.ws + WS_CTL) + CW_QUEUE + 64 * l + 1024 * dup_done;
            for (;;) {
                __syncthreads();
                if (tid == 0) ((LAS unsigned*)(lds + B_END))[0] = __hip_atomic_fetch_add(qctr, 1u, __ATOMIC_RELAXED, __HIP_MEMORY_SCOPE_AGENT);
                __syncthreads();
                const int item = (int)((LAS unsigned*)(lds + B_END))[0];
                if (item >= MB_ITEMS) break;
                int t2 = threadIdx.x; asm volatile("" : "+v"(t2));
                const int lane2 = t2 & 63, wave2 = __builtin_amdgcn_readfirstlane(t2 >> 6);
                mb_item(A, l, item, lds, t2, lane2, wave2);
            }
        } break;
        case 4: fx_rows(A, l, gw, NGW, lane); break;
        default: {
            pg8::Gemm g{(const bf16*)(A.ws + WS_Y), (const bf16*)(A.ws + WS_WOUT), M, DM, DM}; pg8::StaticOrder S; S.init(M, DM, G, bx);
            pg8::EpiResF32 E{A.out, xin, DM};
            pg8::gemm_phase<pg8::EpiResF32, pg8::StaticOrder, true, true>(lds + RING_OFF, g, S, E, tid);
        } break;
        }
        if (DUP_PHASE >= 0 && ph == DUP_PHASE && !dup_done) { dup_done = 1; xcd_barrier(bar); --ph; continue; }
        if (ph + 1 < hi) xcd_barrier(bar);
    }
}

#ifndef RUN_PHASES
#define RUN_PHASES N_PHASES
#endif
#ifndef MK_N_LAUNCHES
#define MK_N_LAUNCHES 1
#endif
extern "C" void kernel_launch(void* const* d_in, const int* in_sizes, int n_in, void* d_out, int out_size, void* d_ws, size_t ws_size, hipStream_t stream) {
    static int grid = 0;
    if (grid == 0) {
        if (n_in != 11 || in_sizes[0] != M * DM || out_size != M * DM || ws_size < WS_END) { fprintf(stderr, "kernel_launch: unexpected shapes (n_in %d, in0 %d, out %d, ws %zu)\n", n_in, n_in > 0 ? in_sizes[0] : -1, out_size, ws_size); grid = -1; return; }
        int dev = 0, cus = 0, per_cu = 0;
        if (hipGetDevice(&dev) != hipSuccess || hipDeviceGetAttribute(&cus, hipDeviceAttributeMultiprocessorCount, dev) != hipSuccess) { grid = -1; return; }
        if (hipFuncSetAttribute((const void*)hymba_fwd, hipFuncAttributeMaxDynamicSharedMemorySize, LDS_BYTES) != hipSuccess) { fprintf(stderr, "kernel_launch: hipFuncSetAttribute failed\n"); grid = -1; return; }
        if (hipOccupancyMaxActiveBlocksPerMultiprocessor(&per_cu, (const void*)hymba_fwd, NTHREADS, LDS_BYTES) != hipSuccess || per_cu < 1) fprintf(stderr, "kernel_launch: occupancy query says %d\n", per_cu);
        (void)hipGetLastError();
        grid = cus;
    }
    if (grid < 0) return;
    (void)hipMemsetAsync((char*)d_ws + WS_CTL, 0, CTL_ZERO_BYTES, stream);
    Args a{};
    for (int i = 0; i < 11; ++i) a.in[i] = (const float*)d_in[i];
    a.out = (float*)d_out; a.ws = (unsigned char*)d_ws;
    constexpr int NL = MK_N_LAUNCHES;
    for (int li = 0; li < NL; ++li) {
        a.ph_lo = (NL == 1) ? 0 : li; a.ph_hi = (NL == 1) ? RUN_PHASES : li + 1;
        hipLaunchKernelGGL(hymba_fwd, dim3(grid), dim3(NTHREADS), LDS_BYTES, stream, a);
    }
}
```

```cpp
#include <hip/hip_runtime.h>
#include <cstdio>
#include <cstdint>
namespace pg8 {
#define PG8_LAS __attribute__((address_space(3)))
typedef unsigned short bf16_t;
typedef short bf16x8 __attribute__((ext_vector_type(8)));
typedef float f32x4 __attribute__((ext_vector_type(4)));
typedef unsigned u32x4 __attribute__((ext_vector_type(4)));
constexpr int BM = 256, BK = 64, HALF = 128, HTB = HALF * BK * 2  , STAGE_BYTES = 8 * HTB, NXCD = 8, WGM = 8;

__host__ __device__ __forceinline__ int lds_byte(int r, int c) { const int st = (r >> 4) * 2 + (c >> 5), rr = r & 15, cc = c & 31, ob = rr * 64 + cc * 2; return st * 1024 + (ob ^ (((ob >> 9) & 1) << 5)); }
__host__ __device__ __forceinline__ void stage_rc(int b, int& R, int& C) { const int st = b / 1024, sb = b % 1024, swz = sb ^ (((sb >> 9) & 1) << 5); R = (st >> 1) * 16 + swz / 64; C = (st & 1) * 32 + (swz % 64) / 2; }
__host__ __device__ __forceinline__ int perm32(int rho) { const int n = rho >> 4, i = rho & 15; return 8 * (i >> 2) + 4 * n + (i & 3); }

struct Unit { int pm, pn; };
struct Gemm { const bf16_t* A; const bf16_t* Bt; int M, N, K; };

struct StaticOrder {
    int nM, nN, nwg, G, c;
    __host__ __device__ void init(int M, int N, int G_, int c_) { nM = M / BM; nN = N / BM; nwg = nM * nN; G = G_; c = c_; }
    __host__ __device__ bool next(int i, Unit& u) const {
        const long L = (long)i * G + c; if (L >= nwg) return false;
        int wgid = (int)L; { const int q = nwg / NXCD, r = nwg % NXCD, xcd = wgid % NXCD, off = wgid / NXCD; wgid = (xcd < r ? xcd * (q + 1) : r * (q + 1) + (xcd - r) * q) + off; }
        const int nig = WGM * nN, gid = wgid / nig, fm = gid * WGM, gsz = (nM - fm) < WGM ? (nM - fm) : WGM;
        u.pm = fm + ((wgid % nig) % gsz); u.pn = (wgid % nig) / gsz; return true;
    }
    __device__ __forceinline__ void a_ready(const Unit&) const {}
    __device__ __forceinline__ void done(const Unit&) const {}
};

__device__ __forceinline__ unsigned cvt_pk_bf16(float lo, float hi) { unsigned r; asm volatile("v_cvt_pk_bf16_f32 %0, %1, %2" : "=v"(r) : "v"(lo), "v"(hi)); return r; }
__device__ __forceinline__ float silu_ep(float x) { return x * __builtin_amdgcn_rcpf(1.f + __builtin_amdgcn_exp2f(-1.4426950408889634f * x)); }
constexpr size_t M_ROWS = 16384;
struct EpiBf16 {
    static constexpr bool PERM = true, AFTER_DRAIN = false;
    bf16_t* O; int ldc; unsigned gate_tiles;
    __device__ __forceinline__ void operator()(const f32x4 (&acc)[2][2][4][2], const Unit& u, int wr, int wc, int fr, int fq) const {
        const int row0 = u.pm * BM + wr * 64 + fr; const int col0 = u.pn * BM + wc * 32 + 8 * fq;
        const bool gate = ((gate_tiles >> u.pn) & 1u) != 0u;
#pragma unroll
        for (int ai = 0; ai < 2; ++ai)
#pragma unroll
            for (int m = 0; m < 4; ++m) { const size_t row = (size_t)(row0 + ai * HALF + m * 16); bf16_t* rowp = O + row * ldc + col0;
#pragma unroll
                for (int bj = 0; bj < 2; ++bj) { f32x4 v0 = acc[ai][bj][m][0], v1 = acc[ai][bj][m][1];
                    if (gate) { v0[0] = silu_ep(v0[0]); v0[1] = silu_ep(v0[1]); v0[2] = silu_ep(v0[2]); v0[3] = silu_ep(v0[3]); v1[0] = silu_ep(v1[0]); v1[1] = silu_ep(v1[1]); v1[2] = silu_ep(v1[2]); v1[3] = silu_ep(v1[3]); }
                    u32x4 w; w.x = cvt_pk_bf16(v0[0], v0[1]); w.y = cvt_pk_bf16(v0[2], v0[3]); w.z = cvt_pk_bf16(v1[0], v1[1]); w.w = cvt_pk_bf16(v1[2], v1[3]);
                    if (ldc) *(u32x4*)(rowp + bj * HALF) = w;
                    else *(u32x4*)(O + ((size_t)(2 * u.pn + bj) * M_ROWS + row) * 128 + wc * 32 + 8 * fq) = w; } }
    }
};
struct EpiResF32 {
    static constexpr bool PERM = false, AFTER_DRAIN = false;
    float* C; const float* R; int ldc;
    __device__ __forceinline__ void operator()(const f32x4 (&acc)[2][2][4][2], const Unit& u, int wr, int wc, int fr, int fq) const {
        const int row0 = u.pm * BM + wr * 64 + fr, col0 = u.pn * BM + wc * 32 + 4 * fq;
#pragma unroll
        for (int ai = 0; ai < 2; ++ai) {
            f32x4 r[4][2][2];
#pragma unroll
            for (int m = 0; m < 4; ++m) { const size_t off = (size_t)(row0 + ai * HALF + m * 16) * ldc + col0;
#pragma unroll
                for (int bj = 0; bj < 2; ++bj)
#pragma unroll
                    for (int n = 0; n < 2; ++n) r[m][bj][n] = *(const f32x4*)(R + off + bj * HALF + n * 16); }
#pragma unroll
            for (int m = 0; m < 4; ++m) { const size_t off = (size_t)(row0 + ai * HALF + m * 16) * ldc + col0;
#pragma unroll
                for (int bj = 0; bj < 2; ++bj)
#pragma unroll
                    for (int n = 0; n < 2; ++n) *(f32x4*)(C + off + bj * HALF + n * 16) = r[m][bj][n] + acc[ai][bj][m][n]; }
        }
    }
};
template <class Epi, class Sched, bool ALIGN_EPI = false, bool SP2 = false>
__device__ __forceinline__ void gemm_phase(PG8_LAS unsigned char* lds, const Gemm g, const Sched& S, const Epi& E, const int tid) {
    const int  wid = __builtin_amdgcn_readfirstlane(tid >> 6), lane = tid & 63, wr = wid >> 2, wc = wid & 3, fr = lane & 15, fq = lane >> 4;
    const int K = g.K, nt = K / BK;
    unsigned voffA[2], voffB[2];
#pragma unroll
    for (int i = 0; i < 2; ++i) { int R, C; stage_rc(tid * 16 + i * 8192, R, C); const int Rb = Epi::PERM ? ((R & ~31) + perm32(R & 31)) : R;
        voffA[i] = (unsigned)(R * K + C) * 2u; voffB[i] = (unsigned)(Rb * K + C) * 2u; }
    const size_t kstep = (size_t)(BK * 2);
    const size_t hstep = (size_t)HALF * K * 2;
    const size_t tstep = 2 * hstep;
    const unsigned ldsw = (unsigned)wid * 1024u;
    const int aoff = lds_byte(wr * 64 + fr, fq * 8), boff = lds_byte(wc * 32 + fr, fq * 8);
#define PG8_SA(b, h) (((b) * 2 + (h)) * HTB)
#define PG8_SB(b, h) ((4 + (b) * 2 + (h)) * HTB)
#define PG8_STAGE(bufoff, gbase, voff) do { _Pragma("unroll") for (int _i = 0; _i < 2; ++_i) \
        __builtin_amdgcn_global_load_lds((const unsigned*)((const char*)(gbase) + (voff)[_i]), (PG8_LAS unsigned*)(lds + (bufoff) + ldsw + _i * 8192), 16, 0, 0); } while (0)
#define PG8_LDA(dst, b, h) do { _Pragma("unroll") for (int m = 0; m < 4; ++m) _Pragma("unroll") for (int k = 0; k < 2; ++k) dst[m][k] = *(const PG8_LAS bf16x8*)(lds + PG8_SA(b, h) + aoff + m * 2048 + k * 1024); } while (0)
#define PG8_LDB(dst, b, h) do { _Pragma("unroll") for (int n = 0; n < 2; ++n) _Pragma("unroll") for (int k = 0; k < 2; ++k) dst[n][k] = *(const PG8_LAS bf16x8*)(lds + PG8_SB(b, h) + boff + n * 2048 + k * 1024); } while (0)
#define PG8_MMA(ai, bj, At, Bt) do { __builtin_amdgcn_s_setprio(1); _Pragma("unroll") for (int m = 0; m < 4; ++m) _Pragma("unroll") for (int n = 0; n < 2; ++n) _Pragma("unroll") for (int k = 0; k < 2; ++k) \
        acc[ai][bj][m][n] = __builtin_amdgcn_mfma_f32_16x16x32_bf16(Bt[n][k], At[m][k], acc[ai][bj][m][n], 0, 0, 0); __builtin_amdgcn_s_setprio(0); } while (0)
#define PG8_WAIT_V(n) asm volatile("s_waitcnt vmcnt(" #n ")" ::: "memory")
#define PG8_WAIT_L(n) asm volatile("s_waitcnt lgkmcnt(" #n ")" ::: "memory")
#define PG8_BAR __builtin_amdgcn_s_barrier()
#define PG8_SCHED __builtin_amdgcn_sched_barrier(0)
    Unit cur, nxt; int ui = 0;
    if (!S.next(0, cur)) return;
    f32x4 acc[2][2][4][2];
#pragma unroll
    for (int a = 0; a < 2; ++a)
#pragma unroll
        for (int b = 0; b < 2; ++b)
#pragma unroll
            for (int m = 0; m < 4; ++m)
#pragma unroll
                for (int n = 0; n < 2; ++n) acc[a][b][m][n] = (f32x4){0.f, 0.f, 0.f, 0.f};
    bf16x8 At[4][2], B0[2][2], B1[2][2];
    const char* cA = (const char*)g.A + (size_t)cur.pm * tstep; const char* cB = (const char*)g.Bt + (size_t)cur.pn * tstep;
    S.a_ready(cur);
    if constexpr (SP2) {
        PG8_STAGE(PG8_SB(0, 0), cB, voffB); PG8_STAGE(PG8_SB(0, 1), cB + hstep, voffB); PG8_STAGE(PG8_SA(0, 0), cA, voffA); PG8_STAGE(PG8_SA(0, 1), cA + hstep, voffA);
        if (wr == 1) PG8_BAR;
        PG8_WAIT_V(2); PG8_BAR;
        PG8_STAGE(PG8_SB(1, 0), cB + kstep, voffB); PG8_STAGE(PG8_SA(1, 0), cA + kstep, voffA); PG8_STAGE(PG8_SB(1, 1), cB + hstep + kstep, voffB);
        PG8_WAIT_V(6); PG8_BAR;
    } else {
        PG8_STAGE(PG8_SB(0, 0), cB, voffB); PG8_STAGE(PG8_SA(0, 0), cA, voffA); PG8_STAGE(PG8_SB(0, 1), cB + hstep, voffB); PG8_STAGE(PG8_SA(0, 1), cA + hstep, voffA);
        if (wr == 1) PG8_BAR;
        PG8_WAIT_V(4); PG8_BAR;
        PG8_STAGE(PG8_SB(1, 0), cB + kstep, voffB); PG8_STAGE(PG8_SA(1, 0), cA + kstep, voffA); PG8_STAGE(PG8_SB(1, 1), cB + hstep + kstep, voffB);
        PG8_WAIT_V(6); PG8_BAR;
    }
    for (;;) {
        const bool has_next = S.next(ui + 1, nxt);
        const char* nA = has_next ? (const char*)g.A + (size_t)nxt.pm * tstep : cA; const char* nB = has_next ? (const char*)g.Bt + (size_t)nxt.pn * tstep : cB;
        for (int t = 0; t < nt; t += 2) {
            const bool last = (t == nt - 2);
            const char* a1 = cA + (size_t)(t + 1) * kstep;
            const char* a2 = last ? nA : cA + (size_t)(t + 2) * kstep; const char* b2 = last ? nB : cB + (size_t)(t + 2) * kstep;
            const char* a3 = a2 + kstep; const char* b3 = b2 + kstep;
            if (last && has_next) S.a_ready(nxt);
            if constexpr (SP2) {
            PG8_LDB(B0, 0, 0); PG8_LDB(B1, 0, 1); PG8_SCHED; PG8_LDA(At, 0, 0); PG8_STAGE(PG8_SA(1, 1), a1 + hstep, voffA);
            PG8_WAIT_V(8); PG8_WAIT_L(0); PG8_BAR; PG8_MMA(0, 0, At, B0); PG8_MMA(0, 1, At, B1); PG8_BAR; PG8_SCHED;
            PG8_LDA(At, 0, 1); PG8_STAGE(PG8_SB(0, 0), b2, voffB); PG8_STAGE(PG8_SB(0, 1), b2 + hstep, voffB); PG8_STAGE(PG8_SA(0, 0), a2, voffA);
            PG8_WAIT_V(8); PG8_WAIT_L(0); PG8_BAR; PG8_MMA(1, 0, At, B0); PG8_MMA(1, 1, At, B1); PG8_BAR; PG8_SCHED;
            PG8_LDB(B0, 1, 0); PG8_LDB(B1, 1, 1); PG8_SCHED; PG8_LDA(At, 1, 0); PG8_STAGE(PG8_SA(0, 1), a2 + hstep, voffA);
            PG8_WAIT_V(8); PG8_WAIT_L(0); PG8_BAR; PG8_MMA(0, 0, At, B0); PG8_MMA(0, 1, At, B1); PG8_BAR; PG8_SCHED;
            PG8_LDA(At, 1, 1); PG8_STAGE(PG8_SB(1, 0), b3, voffB); PG8_STAGE(PG8_SB(1, 1), b3 + hstep, voffB); PG8_STAGE(PG8_SA(1, 0), a3, voffA);
            PG8_WAIT_V(8); PG8_WAIT_L(0); PG8_BAR; PG8_MMA(1, 0, At, B0); PG8_MMA(1, 1, At, B1); PG8_BAR; PG8_SCHED;
            } else {
            PG8_LDB(B0, 0, 0); PG8_SCHED; PG8_LDA(At, 0, 0); PG8_STAGE(PG8_SA(1, 1), a1 + hstep, voffA);
            PG8_WAIT_L(8); PG8_BAR; PG8_WAIT_L(0); PG8_MMA(0, 0, At, B0); PG8_BAR; PG8_SCHED;
            PG8_LDB(B1, 0, 1); PG8_STAGE(PG8_SB(0, 0), b2, voffB);
            PG8_BAR; PG8_WAIT_L(0); PG8_MMA(0, 1, At, B1); PG8_BAR;
            PG8_LDA(At, 0, 1); PG8_STAGE(PG8_SA(0, 0), a2, voffA);
            PG8_BAR; PG8_WAIT_L(0); PG8_MMA(1, 0, At, B0); PG8_BAR; PG8_SCHED;
            PG8_STAGE(PG8_SB(0, 1), b2 + hstep, voffB);
            PG8_WAIT_V(6); PG8_BAR; PG8_MMA(1, 1, At, B1); PG8_BAR;
            PG8_LDB(B0, 1, 0); PG8_SCHED; PG8_LDA(At, 1, 0); PG8_STAGE(PG8_SA(0, 1), a2 + hstep, voffA);
            PG8_WAIT_L(8); PG8_BAR; PG8_WAIT_L(0); PG8_MMA(0, 0, At, B0); PG8_BAR; PG8_SCHED;
            PG8_LDB(B1, 1, 1); PG8_STAGE(PG8_SB(1, 0), b3, voffB);
            PG8_BAR; PG8_WAIT_L(0); PG8_MMA(0, 1, At, B1); PG8_BAR;
            PG8_LDA(At, 1, 1); PG8_STAGE(PG8_SA(1, 0), a3, voffA);
            PG8_BAR; PG8_WAIT_L(0); PG8_MMA(1, 0, At, B0); PG8_BAR; PG8_SCHED;
            PG8_STAGE(PG8_SB(1, 1), b3 + hstep, voffB);
            PG8_WAIT_V(6); PG8_BAR; PG8_MMA(1, 1, At, B1); PG8_BAR;
            }
        }
        if constexpr (ALIGN_EPI) { if (wr == 0) PG8_BAR; }
        if constexpr (!Epi::AFTER_DRAIN) { E(acc, cur, wr, wc, fr, fq); S.done(cur); }
        if (!has_next) break;
#pragma unroll
        for (int a = 0; a < 2; ++a)
#pragma unroll
            for (int b = 0; b < 2; ++b)
#pragma unroll
                for (int m = 0; m < 4; ++m)
#pragma unroll
                    for (int n = 0; n < 2; ++n) acc[a][b][m][n] = (f32x4){0.f, 0.f, 0.f, 0.f};
        cur = nxt; cA = nA; cB = nB; ++ui;
        if constexpr (ALIGN_EPI) { if (wr == 1) PG8_BAR; }
    }
    PG8_WAIT_V(0);
    if constexpr (!ALIGN_EPI) { if (wr == 0) PG8_BAR; }
    PG8_BAR;
    if constexpr (Epi::AFTER_DRAIN) { E.fused(acc, cur, wr, wc, fr, fq, lds, wid, lane); S.done(cur); }
#undef PG8_SA
#undef PG8_SB
#undef PG8_STAGE
#undef PG8_LDA
#undef PG8_LDB
#undef PG8_MMA
#undef PG8_WAIT_V
#undef PG8_WAIT_L
#undef PG8_BAR
#undef PG8_SCHED
}
}
#define GAS __attribute__((address_space(1)))
#define LAS __attribute__((address_space(3)))
typedef unsigned short bf16;
typedef unsigned v4u __attribute__((ext_vector_type(4)));
typedef float f32x4 __attribute__((ext_vector_type(4)));
typedef short bf16x8 __attribute__((ext_vector_type(8)));
typedef GAS unsigned gu32;
typedef GAS unsigned long long gu64;
#define RLX_AGENT __ATOMIC_RELAXED, __HIP_MEMORY_SCOPE_AGENT
#define LDS_WAIT() asm volatile("s_waitcnt lgkmcnt(0)" ::: "memory")
#define VM_WAIT() asm volatile("s_waitcnt vmcnt(0)" ::: "memory")
__device__ __forceinline__ unsigned long long rt() { return __builtin_amdgcn_s_memrealtime(); }
__device__ __forceinline__ unsigned f2bf(float f) { unsigned u = __builtin_bit_cast(unsigned, f); return (u + 0x7fffu + ((u >> 16) & 1u)) >> 16; }
__device__ __forceinline__ unsigned pk2(float lo, float hi) { return f2bf(lo) | (f2bf(hi) << 16); }

#define XB_TMO      128
#define XB_XCNT(j)  (256  + 64 * (j))
#define XB_XSUB(j)  (1280 + 64 * (j))
#define XB_XGEN(j)  (2304 + 64 * (j))
#define XB_TOP      3328
#define XB_TOPGEN   3392
#define XCD_BAR_WORDS 3456
#define XB_SPIN_CAP (1u << 18)

__device__ __forceinline__ unsigned xb_ld(unsigned* p)              { return __hip_atomic_load(p, __ATOMIC_RELAXED, __HIP_MEMORY_SCOPE_AGENT); }
__device__ __forceinline__ unsigned xb_add(unsigned* p, unsigned v) { return __hip_atomic_fetch_add(p, v, __ATOMIC_RELAXED, __HIP_MEMORY_SCOPE_AGENT); }
__device__ __forceinline__ unsigned xb_xcc_id() { return (unsigned)__builtin_amdgcn_s_getreg((3 << 11) | 20) & 0xFu; }
#define XB_SPIN(cond, bar) do { unsigned _sp = 0; while (cond) { __builtin_amdgcn_s_sleep(1); \
    if ((++_sp & 255u) == 0u) { if (xb_ld(&(bar)[XB_TMO])) break; if (_sp > XB_SPIN_CAP) { atomicAdd(&(bar)[XB_TMO], 1u); break; } } } } while (0)

struct XcdBarrier {
    unsigned* bar; unsigned x;
    volatile LAS unsigned* st;
};

__device__ __forceinline__ XcdBarrier xcd_barrier_post(unsigned* bar, volatile LAS unsigned* st) {
    XcdBarrier b; b.bar = bar; b.x = xb_xcc_id(); b.st = st;
    if (threadIdx.x == 0) (void)xb_add(&bar[XB_XCNT(b.x)], 1u);
    return b;
}
__device__ __forceinline__ void xcd_barrier_complete(unsigned* bar, unsigned x, unsigned& nloc, unsigned& nx) {
    const unsigned G = gridDim.x * gridDim.y * gridDim.z;
    unsigned sum, cnt, mine, sp = 0u;
    for (;;) {
        sum = 0u; cnt = 0u; mine = 0u;
#pragma unroll
        for (unsigned j = 0; j < 16; ++j) { const unsigned c = xb_ld(&bar[XB_XCNT(j)]); sum += c; cnt += (c > 0u) ? 1u : 0u; mine = (j == x) ? c : mine; }
        if (sum == G) break;
        __builtin_amdgcn_s_sleep(1);
        if ((++sp & 255u) == 0u) { if (xb_ld(&bar[XB_TMO])) break; if (sp > XB_SPIN_CAP) { atomicAdd(&bar[XB_TMO], 1u); break; } }
    }
    nloc = mine > 0u ? mine : 1u; nx = cnt > 0u ? cnt : 1u;
}

__device__ __forceinline__ void xcd_barrier(const XcdBarrier& b) {
    asm volatile("s_waitcnt vmcnt(0)" ::: "memory");
    __syncthreads();
    if (threadIdx.x == 0) {
        unsigned* bar = b.bar;
        __builtin_amdgcn_s_waitcnt(0);
        unsigned nloc = b.st[0], nx = b.st[1];
        if (nloc == 0u) { xcd_barrier_complete(bar, b.x, nloc, nx); b.st[0] = nloc; b.st[1] = nx; }
        const unsigned old = xb_add(&bar[XB_XSUB(b.x)], 1u);
        const unsigned gen = old / nloc;
        if (old + 1u == (gen + 1u) * nloc) {
            __builtin_amdgcn_fence(__ATOMIC_RELEASE, "agent");
            asm volatile("s_waitcnt vmcnt(0)" ::: "memory");
            const unsigned og = xb_add(&bar[XB_TOP], 1u);
            const unsigned tg = og / nx;
            if (og + 1u == (tg + 1u) * nx) xb_add(&bar[XB_TOPGEN], 1u);
            else XB_SPIN(xb_ld(&bar[XB_TOPGEN]) == tg, bar);
            __builtin_amdgcn_fence(__ATOMIC_ACQUIRE, "agent");
            xb_add(&bar[XB_XGEN(b.x)], 1u);
            asm volatile("s_waitcnt vmcnt(0)" ::: "memory");
        } else {
            XB_SPIN(xb_ld(&bar[XB_XGEN(b.x)]) == gen, bar);
            __builtin_amdgcn_fence(__ATOMIC_ACQUIRE, "agent");
            asm volatile("s_waitcnt vmcnt(0)" ::: "memory");
        }
    }
    __syncthreads();
}

constexpr int NWAVES = 8, NTHREADS = NWAVES * 64;
constexpr int BATCH = 2, T = 8192, DM = 2048, M = BATCH * T, HD = 128, RH = 4, GH = 6, MH = 6, NP = 8192, INW = 8204, DEPTH = 2;
constexpr int C_RQ = 0, C_RK = 512, C_RV = 1024, C_RG = 1536, C_GQ = 2048, C_GK = 2816, C_GV = 3584, C_GZ = 4352, C_MQ = 5120, C_MK = 5888, C_MV = 6656, C_MZ = 7424;
constexpr int NSH = 10;
constexpr float RMS_EPS = 1e-6f;
constexpr int MOBA_BLK = 256, MOBA_NB = T / MOBA_BLK;

constexpr size_t MiB = 1u << 20;
constexpr size_t WS_CTL = 0, CTL_ZERO_BYTES = 1 * MiB;
constexpr size_t WS_WIN = 2 * MiB;
constexpr size_t WS_WOUT = 34 * MiB;
constexpr size_t WS_H = 42 * MiB;
constexpr size_t WS_Y = 42 * MiB;
constexpr size_t WS_GAB = 106 * MiB;
constexpr size_t WS_KMEAN = 107 * MiB;
constexpr size_t WS_PROJ = 108 * MiB;
constexpr size_t WS_GQ = 364 * MiB, WS_GK = 388 * MiB, WS_GV = 412 * MiB, WS_GW = 436 * MiB;
constexpr size_t WS_QKD = 460 * MiB;
constexpr size_t WS_EGS = 480 * MiB;
constexpr size_t WS_ALPHA = 481 * MiB;
constexpr size_t WS_END = 500 * MiB;
constexpr int CW_TMO = 0, CW_CODE = 1, CW_BAR = 4096, CW_QUEUE = 8192, CW_MBCNT = 32768;

constexpr int RING_OFF = 0, RING_BYTES = 131072;
constexpr int QW_OFF = 145408;
constexpr int LDSCTL_OFF = 146432, MISC_OFF = LDSCTL_OFF + 320;
constexpr int LDS_BYTES = 147456;

__device__ __forceinline__ float dpp_f(float v, const int ctrl) { return v; }
#define DPP_ADD(v, ctrl) ((v) + __builtin_bit_cast(float, __builtin_amdgcn_update_dpp(0, __builtin_bit_cast(int, (v)), (ctrl), 0xF, 0xF, true)))
__device__ __forceinline__ float wave_sum(float v) {
    v = DPP_ADD(v, 0xB1);
    v = DPP_ADD(v, 0x4E);
    v = DPP_ADD(v, 0x141);
    v = DPP_ADD(v, 0x140);
    v += __builtin_bit_cast(float, __builtin_amdgcn_update_dpp(0, __builtin_bit_cast(int, v), 0x142, 0xA, 0xF, false));
    v += __builtin_bit_cast(float, __builtin_amdgcn_update_dpp(0, __builtin_bit_cast(int, v), 0x143, 0xC, 0xF, false));
    return __builtin_bit_cast(float, __builtin_amdgcn_readlane(__builtin_bit_cast(int, v), 63));
}
__device__ __forceinline__ float wave_max(float v) {
#pragma unroll
    for (int o = 1; o < 64; o <<= 1) v = fmaxf(v, __shfl_xor(v, o));
    return v;
}
__device__ __forceinline__ float bf2f(unsigned short u) { return __builtin_bit_cast(float, (unsigned)u << 16); }
__device__ __forceinline__ float bflo(unsigned u) { return __builtin_bit_cast(float, u << 16); }
__device__ __forceinline__ float bfhi(unsigned u) { return __builtin_bit_cast(float, u & 0xffff0000u); }
__device__ __forceinline__ float silu_f(float x) { return x / (1.f + expf(-x)); }
__device__ __forceinline__ float silu_fast(float x) { return x * __builtin_amdgcn_rcpf(1.f + __builtin_amdgcn_exp2f(-1.4426950408889634f * x)); }
__device__ __forceinline__ float fexp(float x) { return __builtin_amdgcn_exp2f(1.4426950408889634f * x); }
__device__ __forceinline__ float frsq(float x) { return __builtin_amdgcn_rsqf(x); }

typedef short s16x4 __attribute__((ext_vector_type(4)));
typedef float f32x2v __attribute__((ext_vector_type(2)));
typedef __bf16 bf2v __attribute__((ext_vector_type(2)));
__device__ __forceinline__ unsigned pkbf(float a, float b) { const f32x2v v = {a, b}; const bf2v r = __builtin_convertvector(v, bf2v); return __builtin_bit_cast(unsigned, r); }
__device__ __forceinline__ bf16x8 pack8(const f32x4 a, const f32x4 b) { v4u p; p.x = pkbf(a.x, a.y); p.y = pkbf(a.z, a.w); p.z = pkbf(b.x, b.y); p.w = pkbf(b.z, b.w); return __builtin_bit_cast(bf16x8, p); }
__device__ __forceinline__ bf16x8 ldA2(const LAS unsigned char* p) { const s16x4 lo = *(const volatile LAS s16x4*)p; const s16x4 hi = *(const volatile LAS s16x4*)(p + 32); return __builtin_shufflevector(lo, hi, 0, 1, 2, 3, 4, 5, 6, 7); }
#define MFMA16(a, b, c) __builtin_amdgcn_mfma_f32_16x16x32_bf16((a), (b), (c), 0, 0, 0)
constexpr int NCH = T / 64;
constexpr int SB_SPLIT = 80;

#define PG(P, g) ((P) + (size_t)(g) * M * HD)
constexpr int G_RQ = 0, G_RK = 4, G_RV = 8, G_RG = 12, G_GQ = 16, G_GK = 22, G_GV = 28, G_GZ = 34, G_MQ = 40, G_MK = 46, G_MV = 52, G_MZ = 58;

struct Args { const float* in[11]; float* out; unsigned char* ws; int ph_lo, ph_hi; };

struct TItem { const float* src; bf16* dst; int ldw; };
__device__ __forceinline__ TItem p0_item(const Args& a, int l, int it) {
    constexpr int I_IN = (DM / 64) * (NP / 32);
    TItem t;
    if (it < I_IN) { const int kb = it / (NP / 32), nb = it % (NP / 32), n0 = 32 * nb; const int src = n0 + (n0 >= 5120 ? 12 : 0);
        t.src = a.in[2] + (size_t)l * DM * INW + (size_t)(64 * kb) * INW + src; t.ldw = INW; t.dst = (bf16*)(a.ws + WS_WIN) + (size_t)n0 * DM + 64 * kb; }
    else { const int r = it - I_IN; const int kb = r / (DM / 32), nb = r % (DM / 32), n0 = 32 * nb;
        t.src = a.in[10] + (size_t)l * DM * DM + (size_t)(64 * kb) * DM + n0; t.ldw = DM; t.dst = (bf16*)(a.ws + WS_WOUT) + (size_t)n0 * DM + 64 * kb; }
    return t;
}
__device__ __forceinline__ void p0_weights(const Args& a, int l, LAS unsigned char* lds, int gw, int NGW, int wave, int lane) {
    LAS float* scr = (LAS float*)(lds + RING_OFF + wave * 16384);
    constexpr int NITEMS = (DM / 64) * (NP / 32) + (DM / 64) * (DM / 32);
    f32x4 nv[8]; TItem cur, nxt;
    if (gw < NITEMS) { cur = p0_item(a, l, gw);
#pragma unroll
        for (int i = 0; i < 8; ++i) { const int p = lane + 64 * i; nv[i] = *(const f32x4*)(cur.src + (size_t)(p >> 3) * cur.ldw + 4 * (p & 7)); } }
    for (int it = gw; it < NITEMS; it += NGW) {
        f32x4 v[8];
#pragma unroll
        for (int i = 0; i < 8; ++i) v[i] = nv[i];
        if (it + NGW < NITEMS) { nxt = p0_item(a, l, it + NGW);
#pragma unroll
            for (int i = 0; i < 8; ++i) { const int p = lane + 64 * i; nv[i] = *(const f32x4*)(nxt.src + (size_t)(p >> 3) * nxt.ldw + 4 * (p & 7)); } }
#pragma unroll
        for (int i = 0; i < 8; ++i) { const int p = lane + 64 * i, kk = p >> 3, c4 = p & 7; LAS float* d = scr + kk * 33 + 4 * c4; d[0] = v[i].x; d[1] = v[i].y; d[2] = v[i].z; d[3] = v[i].w; }
        LDS_WAIT(); asm volatile("" ::: "memory");
        const int c = lane & 7;
#pragma unroll
        for (int j = 0; j < 4; ++j) { const int n = (lane >> 3) + 8 * j; const LAS float* s = scr + (8 * c) * 33 + n;
            v4u o; o.x = pkbf(s[0 * 33], s[1 * 33]); o.y = pkbf(s[2 * 33], s[3 * 33]); o.z = pkbf(s[4 * 33], s[5 * 33]); o.w = pkbf(s[6 * 33], s[7 * 33]);
            *(GAS v4u*)(cur.dst + (size_t)n * DM + 8 * c) = o; }
        LDS_WAIT(); asm volatile("" ::: "memory");
        cur = nxt;
    }
}
__device__ __forceinline__ void p0_rows(const Args& a, int l, const float* xin, LAS unsigned char* lds, int gw, int NGW, int tid, int lane) {
    LAS float* wab = (LAS float*)(lds + RING_OFF);
    const float* win = a.in[2] + (size_t)l * DM * INW;
    __syncthreads();
    {
        f32x4 wv[4][3];
#pragma unroll
        for (int r = 0; r < 4; ++r)
#pragma unroll
            for (int q = 0; q < 3; ++q) wv[r][q] = *(const f32x4*)(win + (size_t)(tid + NTHREADS * r) * INW + 5120 + 4 * q);
#pragma unroll
        for (int r = 0; r < 4; ++r)
#pragma unroll
            for (int q = 0; q < 3; ++q) { const int k = tid + NTHREADS * r; wab[(4 * q) * DM + k] = wv[r][q].x; wab[(4 * q + 1) * DM + k] = wv[r][q].y; wab[(4 * q + 2) * DM + k] = wv[r][q].z; wab[(4 * q + 3) * DM + k] = wv[r][q].w; }
    }
    __syncthreads();
    const float* nw = a.in[1] + (size_t)l * DM;
    bf16* H = (bf16*)(a.ws + WS_H); float* GAB = (float*)(a.ws + WS_GAB);
    f32x4 nwv[8];
#pragma unroll
    for (int j = 0; j < 8; ++j) nwv[j] = ((const f32x4*)nw)[lane + 64 * j];
    f32x4 nx[8];
    if (gw < M) {
#pragma unroll
        for (int j = 0; j < 8; ++j) nx[j] = ((const f32x4*)(xin + (size_t)gw * DM) + lane)[64 * j];
    }
    for (int m = gw; m < M; m += NGW) {
        f32x4 v[8]; float ss = 0.f;
#pragma unroll
        for (int j = 0; j < 8; ++j) { v[j] = nx[j]; ss += (v[j].x * v[j].x + v[j].y * v[j].y) + (v[j].z * v[j].z + v[j].w * v[j].w); }
        if (m + NGW < M) {
#pragma unroll
            for (int j = 0; j < 8; ++j) nx[j] = ((const f32x4*)(xin + (size_t)(m + NGW) * DM) + lane)[64 * j];
        }
        ss = wave_sum(ss);
        const float r = 1.0f / sqrtf(ss * (1.f / DM) + RMS_EPS);
        unsigned long long* o8 = (unsigned long long*)(H + (size_t)m * DM) + lane;
#pragma unroll
        for (int j = 0; j < 8; ++j) {
            v[j] = v[j] * r * nwv[j];
            o8[64 * j] = (unsigned long long)pk2(v[j].x, v[j].y) | ((unsigned long long)pk2(v[j].z, v[j].w) << 32);
        }
        float val = 0.f;
#pragma unroll 1
        for (int c = 0; c < 12; ++c) {
            float s = 0.f; f32x4 wv8[8];
#pragma unroll
            for (int j = 0; j < 8; ++j) wv8[j] = *(const LAS f32x4*)(wab + c * DM + 4 * lane + 256 * j);
            __builtin_amdgcn_sched_barrier(0);
#pragma unroll
            for (int j = 0; j < 8; ++j) s += (v[j].x * wv8[j].x + v[j].y * wv8[j].y) + (v[j].z * wv8[j].z + v[j].w * wv8[j].w);
            s = wave_sum(s); val = (lane == c) ? s : val;
        }
        if (lane < 12) {
            float o;
            if (lane < 6) { const float al = a.in[4][l * GH + lane], db = a.in[5][l * GH + lane]; const float z = val + db;
                const float sp = (z > 20.f) ? z : log1pf(expf(z)); o = -expf(al) * sp; }
            else o = 1.f / (1.f + expf(-val));
            GAB[(size_t)m * 12 + lane] = o;
        }
    }
    __syncthreads();
}

constexpr float MB_C1 = 0.12751743074602468f;
__device__ __forceinline__ void mp_item(const Args& a, int l, int item, LAS unsigned char* lds, int tid, int lane, int wave) {
    bf16* P = (bf16*)(a.ws + WS_PROJ);
    const float* qnw = a.in[8] + l * HD; const float* knw = a.in[9] + l * HD;
    const int b = item / MOBA_NB, blk = item - b * MOBA_NB, d0 = 2 * lane;
    const f32x2v qw = *(const f32x2v*)(qnw + d0), kw = *(const f32x2v*)(knw + d0);
    const size_t mbase = (size_t)b * T + (size_t)blk * MOBA_BLK + 32 * wave;
    bf16* base = P + mbase * HD + d0;
    float ks0[MH], ks1[MH];
#pragma unroll
    for (int h = 0; h < MH; ++h) { ks0[h] = 0.f; ks1[h] = 0.f; }
    unsigned cq[MH], ck[MH], nq[MH], nk[MH];
#pragma unroll
    for (int h = 0; h < MH; ++h) { cq[h] = *(const unsigned*)(PG(base, G_MQ + h)); ck[h] = *(const unsigned*)(PG(base, G_MK + h)); }
#pragma unroll 1
    for (int r = 0; r < 32; ++r) {
        bf16* row = base + (size_t)r * HD;
        if (r + 1 < 32) {
#pragma unroll
            for (int h = 0; h < MH; ++h) { nq[h] = *(const unsigned*)(PG(row + HD, G_MQ + h)); nk[h] = *(const unsigned*)(PG(row + HD, G_MK + h)); }
        }
#pragma unroll
        for (int h = 0; h < MH; ++h) {
            const float q0 = bflo(cq[h]), q1 = bfhi(cq[h]), k0 = bflo(ck[h]), k1 = bfhi(ck[h]);
            const float qs = wave_sum(q0 * q0 + q1 * q1), ks = wave_sum(k0 * k0 + k1 * k1);
            const float qr = frsq(qs * (1.f / HD) + RMS_EPS), kr = frsq(ks * (1.f / HD) + RMS_EPS);
            const float kn0 = k0 * kr * kw.x, kn1 = k1 * kr * kw.y;
            *(unsigned*)(PG(row, G_MQ + h)) = pkbf(q0 * qr * qw.x * MB_C1, q1 * qr * qw.y * MB_C1);
            *(unsigned*)(PG(row, G_MK + h)) = pkbf(kn0, kn1);
            ks0[h] += kn0; ks1[h] += kn1;
        }
#pragma unroll
        for (int h = 0; h < MH; ++h) { cq[h] = nq[h]; ck[h] = nk[h]; }
    }
    __syncthreads();
    LAS float* red = (LAS float*)lds;
#pragma unroll
    for (int h = 0; h < MH; ++h) *(LAS f32x2v*)(red + (wave * MH + h) * HD + d0) = (f32x2v){ks0[h], ks1[h]};
    __syncthreads();
    float* KM = (float*)(a.ws + WS_KMEAN);
    for (int i = tid; i < MH * HD; i += NTHREADS) { const int h = i / HD, d = i - h * HD; float sacc = 0.f;
#pragma unroll
        for (int w = 0; w < NWAVES; ++w) sacc += red[(w * MH + h) * HD + d];
        KM[((size_t)(b * MH + h) * MOBA_NB + blk) * HD + d] = sacc * (1.f / MOBA_BLK); }
    __syncthreads();
}
constexpr int SA_QB = 0, SA_KB = 17408, SA_MF = 34816, SA_GC = 52224, SA_BETA = 52480, SA_KT = 52736, SA_VT = 71168, SA_TBB = 89600, SA_TBE = 98816, SA_VB = 108032;
__device__ __forceinline__ void sa_item(const Args& a, int l, int item, LAS unsigned char* lds, int tid, int lane, int wave, unsigned* qctr, unsigned& nxt) {
    const int sh = item / NCH, n = item - sh * NCH, b = sh / NSH, hh = sh - b * NSH;
    const bool delta = hh >= RH; const int h = delta ? hh - RH : hh;
    const int t0 = 64 * n; const size_t m0 = (size_t)b * T + t0;
    const bf16* P = (const bf16*)(a.ws + WS_PROJ); const float* GAB = (const float*)(a.ws + WS_GAB);
    bf16* GQ = (bf16*)(a.ws + WS_GQ); bf16* GK = (bf16*)(a.ws + WS_GK); bf16* GV = (bf16*)(a.ws + WS_GV); bf16* GW = (bf16*)(a.ws + WS_GW);
    const int fr = lane & 15, q4 = lane >> 4, d0 = 2 * lane;
    LAS float* GC = (LAS float*)(lds + SA_GC); LAS float* BETA = (LAS float*)(lds + SA_BETA); LAS float* MF = (LAS float*)(lds + SA_MF);
    const float lng = log1pf(-exp2f(-5.0f - (float)h));
    __syncthreads();
    if (delta) {
        const float* convw = a.in[3] + (size_t)l * 4 * 2304;
        unsigned raw[3][11]; f32x2v cw[3][4];
#pragma unroll
        for (int part = 0; part < 3; ++part) {
            const int c = part * 768 + h * HD + d0; const bf16* pg = PG(P, G_GQ + 6 * part + h) + d0;
#pragma unroll
            for (int j = 0; j < 4; ++j) cw[part][j] = *(const f32x2v*)(convw + j * 2304 + c);
#pragma unroll
            for (int j = 0; j < 11; ++j) { const int tt = t0 + 8 * wave - 3 + j;
                raw[part][j] = (tt >= 0) ? *(const unsigned*)(pg + ((long)m0 + 8 * wave - 3 + j) * HD) : 0u; }
        }
#pragma unroll
        for (int i = 0; i < 8; ++i) {
            const int rr = 8 * wave + i; const size_t m = m0 + rr;
            float o[3][2];
#pragma unroll
            for (int part = 0; part < 3; ++part) { float s0 = 0.f, s1 = 0.f;
#pragma unroll
                for (int j = 0; j < 4; ++j) { s0 += cw[part][j].x * bflo(raw[part][i + j]); s1 += cw[part][j].y * bfhi(raw[part][i + j]); }
                o[part][0] = silu_fast(s0); o[part][1] = silu_fast(s1); }
            const float qs = wave_sum(o[0][0] * o[0][0] + o[0][1] * o[0][1]), ks = wave_sum(o[1][0] * o[1][0] + o[1][1] * o[1][1]);
            const float qr = frsq(qs + RMS_EPS) * 0.08838834764831845f, kr = frsq(ks + RMS_EPS);
            const unsigned qp = pkbf(o[0][0] * qr, o[0][1] * qr), kp = pkbf(o[1][0] * kr, o[1][1] * kr), vp = pkbf(o[2][0], o[2][1]);
            *(unsigned*)(PG(GQ, h) + m * HD + d0) = qp;
            *(LAS unsigned*)(lds + SA_QB + rr * 272 + d0 * 2) = qp; *(LAS unsigned*)(lds + SA_KB + rr * 272 + d0 * 2) = kp; *(LAS unsigned*)(lds + SA_VB + rr * 272 + d0 * 2) = vp;
        }
    } else {
        unsigned rq[8], rk[8];
#pragma unroll
        for (int i = 0; i < 8; ++i) { const size_t mo = (m0 + 8 * wave + i) * HD + d0; rq[i] = *(const unsigned*)(PG(P, G_RQ + h) + mo); rk[i] = *(const unsigned*)(PG(P, G_RK + h) + mo); }
#pragma unroll
        for (int i = 0; i < 8; ++i) { const int rr = 8 * wave + i; *(LAS unsigned*)(lds + SA_QB + rr * 272 + d0 * 2) = rq[i]; *(LAS unsigned*)(lds + SA_KB + rr * 272 + d0 * 2) = rk[i]; }
    }
    if (wave == 7) {
        float g = delta ? GAB[(m0 + lane) * 12 + h] : lng;
#pragma unroll
        for (int o = 1; o < 64; o <<= 1) { const float t = __shfl_up(g, o); if (lane >= o) g += t; }
        GC[lane] = g; BETA[lane] = delta ? GAB[(m0 + lane) * 12 + 6 + h] : 1.0f;
    }
    __syncthreads();
    if (tid == 0) nxt = __hip_atomic_fetch_add(qctr, 1u, __ATOMIC_RELAXED, __HIP_MEMORY_SCOPE_AGENT);
    bf16* QKD = (bf16*)(a.ws + WS_QKD) + ((size_t)sh * NCH + n) * 4096;
    const int ntiles = delta ? 20 : 10;
    for (int p = wave; p < ntiles; p += 8) {
        const bool isqk = p < 10; const int pp = isqk ? p : p - 10;
        const int it = (pp >= 6) ? 3 : (pp >= 3) ? 2 : (pp >= 1) ? 1 : 0, jt = pp - (it * (it + 1)) / 2;
        const LAS unsigned char* Ab = lds + (isqk ? SA_QB : SA_KB) + (16 * it + fr) * 272 + q4 * 16;
        const LAS unsigned char* Bb = lds + SA_KB + (16 * jt + fr) * 272 + q4 * 16;
        f32x4 acc = {0.f, 0.f, 0.f, 0.f};
#pragma unroll
        for (int ks = 0; ks < 4; ++ks) acc = MFMA16(*(const LAS bf16x8*)(Ab + 64 * ks), *(const LAS bf16x8*)(Bb + 64 * ks), acc);
        const int j = 16 * jt + fr; const float gj = GC[j];
#pragma unroll
        for (int r = 0; r < 4; ++r) {
            const int i = 16 * it + 4 * q4 + r; const float gi = GC[i];
            const float dec = fexp(fminf(gi - gj, 0.f));
            if (isqk) { const float val = (i >= j) ? acc[r] * dec * (delta ? 1.0f : 0.08838834764831845f) : 0.f; QKD[i * 64 + j] = (bf16)(pkbf(val, 0.f) & 0xffffu); }
            else { MF[i * 68 + j] = (i > j) ? BETA[i] * acc[r] * dec : 0.f; }
        }
    }
    {
#pragma unroll
        for (int u = 0; u < 2; ++u) { const int pck = wave + 8 * u;
            const v4u kk4 = *(const LAS v4u*)(lds + SA_KB + lane * 272 + pck * 16);
            const unsigned kw[4] = {kk4.x, kk4.y, kk4.z, kk4.w};
#pragma unroll
            for (int jj = 0; jj < 8; ++jj) *(LAS unsigned short*)(lds + SA_KT + (pck * 8 + jj) * 144 + lane * 2) = (unsigned short)((jj & 1) ? (kw[jj >> 1] >> 16) : (kw[jj >> 1] & 0xffffu));
            if (delta) { const v4u vv4 = *(const LAS v4u*)(lds + SA_VB + lane * 272 + pck * 16); const unsigned vw[4] = {vv4.x, vv4.y, vv4.z, vv4.w};
#pragma unroll
                for (int jj = 0; jj < 8; ++jj) *(LAS unsigned short*)(lds + SA_VT + (pck * 8 + jj) * 144 + lane * 2) = (unsigned short)((jj & 1) ? (vw[jj >> 1] >> 16) : (vw[jj >> 1] & 0xffffu)); } }
    }
    for (int idx = tid; idx < 6 * 256; idx += NTHREADS) {
        const int u = idx >> 8, e = idx & 255; const int it = (u < 3) ? 0 : (u < 5) ? 1 : 2, jt = (u < 3) ? u + 1 : (u < 5) ? u - 1 : 3;
        QKD[(16 * it + (e >> 4)) * 64 + 16 * jt + (e & 15)] = 0;
        if (delta) MF[(16 * it + (e >> 4)) * 68 + 16 * jt + (e & 15)] = 0.f;
    }
    __syncthreads();
    {
        bf16* ktd = (delta ? PG(GK, h) : PG((bf16*)(a.ws + WS_PROJ), G_RK + h)) + m0 * HD;
#pragma unroll
        for (int u = 0; u < 2; ++u) { const int p = tid + NTHREADS * u, d = p >> 3, pc = p & 7; *(v4u*)(ktd + d * 64 + pc * 8) = *(const LAS v4u*)(lds + SA_KT + d * 144 + pc * 16); }
    }
    if (delta) {
        const int bh6 = b * GH + h;
        if (wave == 0) {
            {
                const int ab = lane >> 4, cc = lane & 15;
                LAS float* mb = MF + (16 * ab) * 68 + 16 * ab;
                float Td[16];
#pragma unroll
                for (int r = 0; r < 16; ++r) {
                    f32x4 mr[4];
#pragma unroll
                    for (int j4 = 0; j4 < (r + 3) / 4; ++j4) mr[j4] = *(const LAS f32x4*)(mb + r * 68 + 4 * j4);
                    __builtin_amdgcn_sched_barrier(0);
                    float a0 = (cc == r) ? 1.f : 0.f, a1 = 0.f;
#pragma unroll
                    for (int j = 0; j < r; ++j) { if (j & 1) a1 -= mr[j >> 2][j & 3] * Td[j]; else a0 -= mr[j >> 2][j & 3] * Td[j]; }
                    Td[r] = a0 + a1;
                    __builtin_amdgcn_sched_barrier(0);
                }
#pragma unroll
                for (int r = 0; r < 16; ++r) mb[r * 68 + cc] = Td[r];
            }
            LDS_WAIT(); asm volatile("" ::: "memory");
#pragma unroll
            for (int ar = 1; ar < 4; ++ar) {
                f32x4 Rt[3];
#pragma unroll
                for (int nb = 0; nb < ar; ++nb) {
                    f32x4 acc = {0.f, 0.f, 0.f, 0.f};
#pragma unroll
                    for (int ks = 0; ks < (ar + 1) / 2; ++ks) {
                        const int k0 = 32 * ks + 8 * q4;
                        f32x4 l0 = *(const LAS f32x4*)(MF + (16 * ar + fr) * 68 + k0), l1 = *(const LAS f32x4*)(MF + (16 * ar + fr) * 68 + k0 + 4);
                        if (k0 >= 16 * ar) { l0 = (f32x4){0.f, 0.f, 0.f, 0.f}; l1 = l0; }
                        f32x4 t0 = {MF[(k0 + 0) * 68 + 16 * nb + fr], MF[(k0 + 1) * 68 + 16 * nb + fr], MF[(k0 + 2) * 68 + 16 * nb + fr], MF[(k0 + 3) * 68 + 16 * nb + fr]};
                        f32x4 t1 = {MF[(k0 + 4) * 68 + 16 * nb + fr], MF[(k0 + 5) * 68 + 16 * nb + fr], MF[(k0 + 6) * 68 + 16 * nb + fr], MF[(k0 + 7) * 68 + 16 * nb + fr]};
                        acc = MFMA16(pack8(l0, l1), pack8(t0, t1), acc);
                    }
                    Rt[nb] = acc;
                }
                const f32x4 td = *(const LAS f32x4*)(MF + (16 * ar + fr) * 68 + 16 * ar + 4 * q4);
                const f32x4 z4 = {0.f, 0.f, 0.f, 0.f};
                const bf16x8 ta = pack8(td, z4);
#pragma unroll
                for (int nb = 0; nb < ar; ++nb) {
                    const f32x4 tn = MFMA16(ta, pack8(Rt[nb], z4), z4);
#pragma unroll
                    for (int r = 0; r < 4; ++r) MF[(16 * ar + 4 * q4 + r) * 68 + 16 * nb + fr] = -tn[r];
                }
                LDS_WAIT(); asm volatile("" ::: "memory");
            }
        } else if (wave == 1) {
            float* EGS = (float*)(a.ws + WS_EGS) + ((size_t)bh6 * T + t0 + lane) * 2;
            const float gl = GC[63], gi = GC[lane];
            EGS[0] = fexp(gi); EGS[1] = fexp(gl - gi);
            if (lane == 0) ((float*)(a.ws + WS_ALPHA))[bh6 * NCH + n] = fexp(gl);
        }
        __syncthreads();
        {
            const int row = tid >> 3, c0 = (tid & 7) * 8;
            const f32x4 t0v = *(const LAS f32x4*)(MF + row * 68 + c0), t1v = *(const LAS f32x4*)(MF + row * 68 + c0 + 4);
            const f32x4 b0 = *(const LAS f32x4*)(BETA + c0), b1 = *(const LAS f32x4*)(BETA + c0 + 4);
            const f32x4 g0 = *(const LAS f32x4*)(GC + c0), g1 = *(const LAS f32x4*)(GC + c0 + 4);
            const f32x4 x0 = t0v * b0, x1 = t1v * b1;
            const f32x4 e0v = {fexp(g0.x), fexp(g0.y), fexp(g0.z), fexp(g0.w)}, e1v = {fexp(g1.x), fexp(g1.y), fexp(g1.z), fexp(g1.w)};
            *(LAS bf16x8*)(lds + SA_TBB + row * 144 + c0 * 2) = pack8(x0, x1);
            *(LAS bf16x8*)(lds + SA_TBE + row * 144 + c0 * 2) = pack8(x0 * e0v, x1 * e1v);
        }
        __syncthreads();
#pragma unroll
        for (int which = 0; which < 2; ++which) {
            const LAS unsigned char* Ab = lds + (which ? SA_VT : SA_KT) + (16 * wave + fr) * 144 + q4 * 16;
            bf16* dst = PG(which ? GV : GW, h) + m0 * HD + 16 * wave + 4 * q4;
#pragma unroll
            for (int it = 0; it < 4; ++it) {
                const LAS unsigned char* Bb = lds + (which ? SA_TBB : SA_TBE) + (16 * it + fr) * 144 + q4 * 16;
                f32x4 acc = {0.f, 0.f, 0.f, 0.f};
#pragma unroll
                for (int ks = 0; ks < 2; ++ks) acc = MFMA16(*(const LAS bf16x8*)(Ab + 64 * ks), *(const LAS bf16x8*)(Bb + 64 * ks), acc);
                uint2 o; o.x = pkbf(acc[0], acc[1]); o.y = pkbf(acc[2], acc[3]);
                *(uint2*)(dst + (size_t)(16 * it + fr) * HD) = o;
            }
        }
    }
    __syncthreads();
}

constexpr int B_KB = 0, B_QB = 17408, B_KT = 34816, B_QD = 53248, B_V = 62464, B_EG = 71680, B_BUF = 72704;
constexpr int B_END = QW_OFF;
#define SCHED_FENCE() __builtin_amdgcn_sched_barrier(0)
template <bool DELTA, bool FULL>
__device__ __forceinline__ void sb_chunk(f32x4 (&S)[8], const LAS unsigned char* lds, const LAS unsigned char* a272, const LAS unsigned char* a144, const LAS unsigned char* vcol, const LAS float* EG, int q4, bf16* ybase) {
    constexpr bool delta = DELTA;
        {
        bf16x8 Sb[4];
#pragma unroll
        for (int s = 0; s < 4; ++s) Sb[s] = pack8(S[2 * s], S[2 * s + 1]);
        bf16x8 fk[4], fq[4], gk[4], gq[4];
        unsigned short vr[16]; f32x4 egv[4];
#pragma unroll
        for (int it = 0; it < 4; ++it) { egv[it] = *(const LAS f32x4*)(EG + 16 * it + 4 * q4);
#pragma unroll
            for (int r = 0; r < 4; ++r) vr[4 * it + r] = *(const LAS unsigned short*)(vcol + (16 * it + r) * 144); }
#pragma unroll
        for (int s = 0; s < 4; ++s) { if (delta) fk[s] = ldA2(a272 + B_KB + 64 * s); if (FULL) fq[s] = ldA2(a272 + B_QB + 64 * s); }
        SCHED_FENCE();
        f32x4 R[4], qs[4];
#define SB_KQ(it, FK, FQ, NK, NQ) do { \
            if ((it) < 3) { _Pragma("unroll") for (int s = 0; s < 4; ++s) { if (delta) NK[s] = ldA2(a272 + B_KB + (16 * ((it) + 1)) * 272 + 64 * s); if (FULL) NQ[s] = ldA2(a272 + B_QB + (16 * ((it) + 1)) * 272 + 64 * s); } } \
            f32x4 ks = {0.f, 0.f, 0.f, 0.f}; qs[it] = (f32x4){0.f, 0.f, 0.f, 0.f}; \
            _Pragma("unroll") for (int s = 0; s < 4; ++s) { if (delta) ks = MFMA16(FK[s], Sb[s], ks); if (FULL) qs[it] = MFMA16(FQ[s], Sb[s], qs[it]); } \
            _Pragma("unroll") for (int r = 0; r < 4; ++r) { const float v = bf2f(vr[4 * (it) + r]); R[it][r] = delta ? v - ks[r] : v; } \
            qs[it] = qs[it] * egv[it]; \
            SCHED_FENCE(); } while (0)
        SB_KQ(0, fk, fq, gk, gq); SB_KQ(1, gk, gq, fk, fq); SB_KQ(2, fk, fq, gk, gq);
        bf16x8 fd[8];
#pragma unroll
        for (int i = 0; i < 8; ++i) { if (FULL) fd[i] = ldA2(a144 + B_QD + (16 * (i >> 1)) * 144 + 64 * (i & 1)); }
        SB_KQ(3, gk, gq, fk, fq);
#undef SB_KQ
        bf16x8 Rb[2];
#pragma unroll
        for (int s = 0; s < 2; ++s) Rb[s] = pack8(R[2 * s], R[2 * s + 1]);
        f32x4 vn[4]; bf16x8 VNb[2];
#pragma unroll
        for (int it = 0; it < 4; ++it) vn[it] = R[it];
        VNb[0] = Rb[0]; VNb[1] = Rb[1];
        bf16x8 VSb[2];
#pragma unroll
        for (int s = 0; s < 2; ++s) { const f32x4 g0 = *(const LAS f32x4*)(EG + 64 + 32 * s + 4 * q4), g1 = *(const LAS f32x4*)(EG + 64 + 32 * s + 16 + 4 * q4); VSb[s] = pack8(g0 * vn[2 * s], g1 * vn[2 * s + 1]); }
        const float alpha = EG[128];
        bf16x8 fs[8];
#pragma unroll
        for (int i = 0; i < 8; ++i) fs[i] = ldA2(a144 + B_KT + (16 * (i >> 1)) * 144 + 64 * (i & 1));
        if (FULL) {
#pragma unroll
        for (int it = 0; it < 4; ++it) { f32x4 o = qs[it];
#pragma unroll
            for (int s = 0; s < 2; ++s) o = MFMA16(fd[2 * it + s], VNb[s], o);
            bf16* yp = ybase + (size_t)(16 * it) * DM;
            const unsigned o01 = pkbf(o[0], o[1]), o23 = pkbf(o[2], o[3]);
            yp[0] = (bf16)(o01 & 0xffffu); yp[DM] = (bf16)(o01 >> 16); yp[2 * DM] = (bf16)(o23 & 0xffffu); yp[3 * DM] = (bf16)(o23 >> 16); }
        }
        SCHED_FENCE();
        bf16x8 fs2[8];
#pragma unroll
        for (int i = 0; i < 8; ++i) fs2[i] = ldA2(a144 + B_KT + (16 * (4 + (i >> 1))) * 144 + 64 * (i & 1));
#pragma unroll
        for (int dt = 0; dt < 4; ++dt) { S[dt] = S[dt] * alpha;
#pragma unroll
            for (int s = 0; s < 2; ++s) S[dt] = MFMA16(fs[2 * dt + s], VSb[s], S[dt]); }
        SCHED_FENCE();
#pragma unroll
        for (int dt = 4; dt < 8; ++dt) { S[dt] = S[dt] * alpha;
#pragma unroll
            for (int s = 0; s < 2; ++s) S[dt] = MFMA16(fs2[2 * (dt - 4) + s], VSb[s], S[dt]); }
        }
}
#undef SCHED_FENCE

template <bool DELTA>
__device__ __forceinline__ void sb_item(const Args& a, int l, int sh, int half, int nfull, int nend, LAS unsigned char* lds, int tid, int lane, int wave) {
    const int b = sh / NSH, hh = sh - b * NSH; constexpr bool delta = DELTA; const int h = delta ? hh - RH : hh, bh6 = b * GH + h;
    const bf16* P = (const bf16*)(a.ws + WS_PROJ); bf16* Y = (bf16*)(a.ws + WS_Y);
    const bf16* qg = delta ? PG((const bf16*)(a.ws + WS_GQ), h) : PG(P, G_RQ + h);
    const bf16* kg = delta ? PG((const bf16*)(a.ws + WS_GK), h) : PG(P, G_RK + h);
    const bf16* vg = delta ? PG((const bf16*)(a.ws + WS_GV), h) : PG(P, G_RV + h);
    constexpr size_t ld = HD; const size_t m0 = (size_t)b * T;
    const bf16* wg = PG((const bf16*)(a.ws + WS_GW), h); const bf16* QDp = (const bf16*)(a.ws + WS_QKD) + (size_t)sh * NCH * 4096;
    const float* EGS = (const float*)(a.ws + WS_EGS) + (size_t)bh6 * T * 2; const float* ALPHA = (const float*)(a.ws + WS_ALPHA) + bh6 * NCH;
    const int gcol = delta ? C_GZ + h * HD : C_RG + h * HD, ycol = delta ? 512 + h * HD : h * HD;
    const float* nw = delta ? a.in[7] + (size_t)l * HD : a.in[6] + ((size_t)l * RH + h) * HD;
    const int fr = lane & 15, q4 = lane >> 4, e0 = 64 * half + 16 * (wave & 3);
    const bool cw = wave < 4;
    struct PF { v4u pk[4], pw[4], pq[4], pv[2], pd[2]; float peg; };
    PF fa, fb;
    const int ht = tid - 256, hw = wave - 4;
#define SB_LOAD(F, nn) do { \
        _Pragma("unroll") for (int u = 0; u < 4; ++u) { \
            F.pk[u] = *(const v4u*)(kg + (m0 + 64 * (nn)) * ld + (ht + 256 * u) * 8); \
            const int p = ht + 256 * u, row = p >> 4, pc = p & 15; \
            F.pq[u] = *(const v4u*)(qg + (m0 + 64 * (nn) + row) * ld + pc * 8); \
            if (delta) F.pw[u] = *(const v4u*)(wg + (m0 + 64 * (nn) + row) * ld + pc * 8); } \
        _Pragma("unroll") for (int u = 0; u < 2; ++u) { const int p = ht + 256 * u; const size_t off = (size_t)(nn) * 4096 + (p >> 3) * 64 + (p & 7) * 8; F.pd[u] = *(const v4u*)(QDp + off); \
            F.pv[u] = *(const v4u*)(vg + (m0 + 64 * (nn) + (p >> 3)) * ld + 64 * half + (p & 7) * 8); } \
        if (delta) { const float* pp = (ht < 128) ? EGS + (64 * (nn) + (ht & 63)) * 2 + (ht >> 6) : ALPHA + (nn); F.peg = *pp; } \
    } while (0)
#define SB_STORE(F, BO, WQ) do {        \
        _Pragma("unroll") for (int u = 0; u < 4; ++u) { \
            const int p = ht + 256 * u, row = p >> 4, pc = p & 15; \
            *(LAS v4u*)(lds + (BO) + B_KT + (p >> 3) * 144 + (p & 7) * 16) = F.pk[u]; \
            if (delta) *(LAS v4u*)(lds + (BO) + B_KB + row * 272 + pc * 16) = F.pw[u]; } \
        _Pragma("unroll") for (int u = 0; u < 2; ++u) { const int p = ht + 256 * u, row = p >> 3, pc = p & 7; *(LAS v4u*)(lds + (BO) + B_V + row * 144 + pc * 16) = F.pv[u]; } \
        if (WQ) { \
            _Pragma("unroll") for (int u = 0; u < 4; ++u) { const int p = ht + 256 * u, row = p >> 4, pc = p & 15; *(LAS v4u*)(lds + (BO) + B_QB + row * 272 + pc * 16) = F.pq[u]; } \
            _Pragma("unroll") for (int u = 0; u < 2; ++u) { const int p = ht + 256 * u, row = p >> 3, pc = p & 7; *(LAS v4u*)(lds + (BO) + B_QD + row * 144 + pc * 16) = F.pd[u]; } } \
        if (delta && ht < 129) ((LAS float*)(lds + (BO) + B_EG))[ht] = F.peg; \
    } while (0)
    __syncthreads();
    if (!delta) {
        const float lng = log1pf(-exp2f(-5.0f - (float)h));
        float ev = 0.f;
        if (tid < 64) ev = expf((float)(tid + 1) * lng);
        else if (tid < 128) ev = 0.08838834764831845f * expf((float)(127 - tid) * lng);
        else if (tid == 128) ev = expf(64.f * lng);
        if (tid < 129) { ((LAS float*)(lds + B_EG))[tid] = ev; ((LAS float*)(lds + B_BUF + B_EG))[tid] = ev; }
    }
    if (!cw) { SB_LOAD(fa, 0); SB_STORE(fa, 0, nfull == 0); SB_LOAD(fa, 1); { const int nl = (2 < nend) ? 2 : nend - 1; SB_LOAD(fb, nl); } }
    __syncthreads();
    f32x4 S[8];
#pragma unroll
    for (int dt = 0; dt < 8; ++dt) S[dt] = (f32x4){0.f, 0.f, 0.f, 0.f};
    const int o272 = fr * 272 + 8 * q4, o144 = fr * 144 + 8 * q4, ovc = B_V + (4 * q4) * 144 + (16 * (wave & 3) + fr) * 2;
#define SCHED_FENCE() __builtin_amdgcn_sched_barrier(0)
    if (!cw) {
#pragma unroll 1
        for (int n2 = 0; n2 < nend; n2 += 2) {
            SB_STORE(fa, B_BUF, n2 + 1 >= nfull);
            { const int nl = (n2 + 3 < nend) ? n2 + 3 : nend - 1; SB_LOAD(fa, nl); }
            __syncthreads();
            SB_STORE(fb, 0, n2 + 2 >= nfull);
            { const int nl = (n2 + 4 < nend) ? n2 + 4 : nend - 1; SB_LOAD(fb, nl); }
            __syncthreads();
        }
    } else {
    bf16* yb0 = Y + (m0 + 4 * q4) * DM + ycol + e0 + fr;
#pragma unroll 1
    for (int n = 0; n < nfull; ++n) {
        const LAS unsigned char* bb = lds + (n & 1) * B_BUF;
        sb_chunk<DELTA, false>(S, lds, bb + o272, bb + o144, bb + ovc, (const LAS float*)(bb + B_EG), q4, yb0);
        __syncthreads();
    }
#pragma unroll 1
    for (int n = nfull; n < nend; ++n) {
        const LAS unsigned char* bb = lds + (n & 1) * B_BUF;
        sb_chunk<DELTA, true>(S, lds, bb + o272, bb + o144, bb + ovc, (const LAS float*)(bb + B_EG), q4, yb0 + (size_t)(64 * n) * DM);
        __syncthreads();
    }
    }
#undef SCHED_FENCE
#undef SB_LOAD
#undef SB_STORE
}
__device__ __forceinline__ void fx_rows(const Args& a, int l, int gw, int NGW, int lane) {
    const bf16* P = (const bf16*)(a.ws + WS_PROJ); bf16* Y = (bf16*)(a.ws + WS_Y);
    const float* rnw = a.in[6] + (size_t)l * RH * HD; const float* gnw = a.in[7] + (size_t)l * HD;
    const int d0 = 2 * lane;
    f32x2v wr[RH];
#pragma unroll
    for (int h = 0; h < RH; ++h) wr[h] = *(const f32x2v*)(rnw + h * HD + d0);
    const f32x2v wg = *(const f32x2v*)(gnw + d0);
    for (int m = gw; m < M; m += NGW) {
        unsigned ou[NSH], zu[NSH];
#pragma unroll
        for (int hh = 0; hh < NSH; ++hh) { ou[hh] = *(const unsigned*)(Y + (size_t)m * DM + hh * HD + d0);
            zu[hh] = *(const unsigned*)(PG(P, (hh < RH) ? (G_RG + hh) : (G_GZ + hh - RH)) + (size_t)m * HD + d0); }
#pragma unroll
        for (int hh = 0; hh < NSH; ++hh) {
            const float ox = bflo(ou[hh]), oy = bfhi(ou[hh]);
            const float rs = __builtin_amdgcn_rsqf(wave_sum(ox * ox + oy * oy) * (1.f / HD) + RMS_EPS);
            const f32x2v w = (hh < RH) ? wr[hh < RH ? hh : 0] : wg;
            *(unsigned*)(Y + (size_t)m * DM + hh * HD + d0) = pkbf(ox * rs * w.x * silu_fast(bflo(zu[hh])), oy * rs * w.y * silu_fast(bfhi(zu[hh])));
        }
    }
}

typedef float f32x16 __attribute__((ext_vector_type(16)));
#define MFMA32(a, b, c) __builtin_amdgcn_mfma_f32_32x32x16_bf16((a), (b), (c), 0, 0, 0)
constexpr int MB_KM = 0, MB_K0 = 16384, MB_V0 = 49152, MB_VSZ = 17408, MB_TL = 83968, MB_UN = 84480, MB_END = 84608;
constexpr int MB_ENTRIES = 224, MB_ITEMS = BATCH * MB_ENTRIES, MB_SLOTS = 32;
__device__ const unsigned short mb_order[MB_ENTRIES] = {32509, 32765, 124, 125, 30453, 30709, 28397, 28653, 116, 117, 31484, 31740, 29428, 29684, 27372, 27628, 25316, 25572, 26341, 26597, 23260, 23516, 24285, 24541, 108, 109, 21204, 21460, 22229, 22485, 19148, 19404, 20173, 20429, 100, 101, 17092, 17348, 18117, 18373, 251, 243, 235, 227, 219, 211, 203, 195, 187, 15036, 15292, 16061, 16317, 179, 171, 163, 155, 147, 139, 131, 123, 115, 107, 99, 91, 92, 93, 12980, 13236, 14005, 14261, 10924, 11180, 11949, 12205, 83, 84, 85, 8868, 9124, 9893, 10149, 6812, 7068, 7837, 8093, 75, 76, 77, 4756, 5012, 5781, 6037, 2700, 2956, 3725, 3981, 67, 68, 69, 644, 900, 1669, 1925, 59, 60, 61, 51, 52, 53, 250, 242, 234, 226, 218, 210, 202, 194, 186, 178, 170, 162, 154, 146, 138, 130, 122, 114, 106, 98, 90, 82, 74, 66, 58, 50, 42, 43, 44, 45, 34, 35, 36, 37, 26, 27, 28, 29, 249, 241, 233, 225, 217, 209, 201, 193, 185, 177, 169, 161, 153, 145, 137, 129, 121, 113, 105, 97, 89, 81, 73, 65, 57, 49, 41, 33, 25, 17, 18, 19, 20, 21, 248, 240, 232, 224, 216, 208, 200, 192, 184, 176, 168, 160, 152, 144, 136, 128, 120, 112, 104, 96, 88, 80, 72, 64, 56, 48, 40, 32, 24, 16, 8, 9, 10, 11, 12, 13, 0, 1, 2, 3, 4, 5};
constexpr size_t WS_MBP = 482 * MiB;
__device__ __forceinline__ void mb_item(const Args& a, int l, int item, LAS unsigned char* lds, int tid, int lane, int wave) {
    const int oe = (int)mb_order[item >> 1], qb = (oe >> 3) & 31, h = oe & 7, piece = (oe >> 8) & 1, npieces = ((oe >> 9) & 1) + 1, slot = (oe >> 10) + MB_SLOTS * (item & 1), b = item & 1, bh = b * MH + h, own = qb;
    const bf16* P = (const bf16*)(a.ws + WS_PROJ); bf16* Y = (bf16*)(a.ws + WS_Y);
    const int ql = lane & 31, hh = lane >> 5;
    const int tq0 = MOBA_BLK * qb, tq = tq0 + 32 * wave + ql;
    const size_t mrow = (size_t)b * T + tq;
    const float NEG = -__builtin_inff();
    const float c2v = exp2f(-8.0f * (float)(h + 1) / (float)MH) * 1.4426950408889634f;
    const float c2 = __builtin_bit_cast(float, __builtin_amdgcn_readfirstlane(__builtin_bit_cast(int, c2v)));
    const int reach = (int)((100.0f / c2 - 1.0f) * (1.0f / MOBA_BLK)) + 1;
    bf16x8 Qf[8];
#pragma unroll
    for (int ks = 0; ks < 8; ++ks) Qf[ks] = *(const bf16x8*)(PG(P, G_MQ + h) + mrow * HD + 16 * ks + 8 * hh);
    __syncthreads();
    { const float* KM = (const float*)(a.ws + WS_KMEAN) + (size_t)bh * MOBA_NB * HD; LAS float* km = (LAS float*)(lds + MB_KM);
      for (int i = tid; i < MOBA_NB * HD / 4; i += NTHREADS) ((LAS f32x4*)km)[i] = ((const f32x4*)KM)[i]; }
    __syncthreads();
    unsigned selmask = 0u;
    {
        float qf[64];
#pragma unroll
        for (int ks = 0; ks < 8; ++ks) { const v4u u = __builtin_bit_cast(v4u, Qf[ks]);
            qf[8 * ks] = bflo(u.x); qf[8 * ks + 1] = bfhi(u.x); qf[8 * ks + 2] = bflo(u.y); qf[8 * ks + 3] = bfhi(u.y); qf[8 * ks + 4] = bflo(u.z); qf[8 * ks + 5] = bfhi(u.z); qf[8 * ks + 6] = bflo(u.w); qf[8 * ks + 7] = bfhi(u.w); }
        float v1 = NEG, v2 = NEG, v3 = NEG; int i1 = 0, i2 = 0, i3 = 0;
#pragma unroll 1
        for (int n = 0; n < own; ++n) {
            const LAS float* kr = (const LAS float*)(lds + MB_KM) + n * HD + 8 * hh;
            float g0 = 0.f, g1 = 0.f;
#pragma unroll
            for (int ks = 0; ks < 8; ++ks) { const f32x4 ka = *(const LAS f32x4*)(kr + 16 * ks), kb = *(const LAS f32x4*)(kr + 16 * ks + 4);
                g0 += (qf[8 * ks] * ka.x + qf[8 * ks + 1] * ka.y) + (qf[8 * ks + 2] * ka.z + qf[8 * ks + 3] * ka.w);
                g1 += (qf[8 * ks + 4] * kb.x + qf[8 * ks + 5] * kb.y) + (qf[8 * ks + 6] * kb.z + qf[8 * ks + 7] * kb.w); }
            float g = g0 + g1; g += __shfl_xor(g, 32);
            if (g > v1) { v3 = v2; i3 = i2; v2 = v1; i2 = i1; v1 = g; i1 = n; }
            else if (g > v2) { v3 = v2; i3 = i2; v2 = g; i2 = n; }
            else if (g > v3) { v3 = g; i3 = n; }
        }
        if (v1 > NEG) selmask |= 1u << i1;
        if (v2 > NEG) selmask |= 1u << i2;
        if (v3 > NEG) selmask |= 1u << i3;
    }
    {
        unsigned u = selmask;
#pragma unroll
        for (int o = 1; o < 64; o <<= 1) u |= __shfl_xor(u, o);
        if (lane == 0) ((LAS unsigned*)(lds + MB_UN))[wave] = u;
        __syncthreads();
        if (tid == 0) {
            unsigned un = 0u;
            for (int w = 0; w < NWAVES; ++w) un |= ((LAS unsigned*)(lds + MB_UN))[w];
            LAS unsigned short* tl = (LAS unsigned short*)(lds + MB_TL); int cnt = 0;
            for (int kt = 0; kt < 4; ++kt) tl[cnt++] = (unsigned short)(own * MOBA_BLK + 64 * kt);
            for (int j = own - 1; j >= 0 && own - j <= reach; --j) if ((un >> j) & 1u) for (int kt = 0; kt < 4; ++kt) tl[cnt++] = (unsigned short)(j * MOBA_BLK + 64 * kt);
            ((LAS unsigned*)(lds + MB_UN))[8] = (unsigned)cnt;
        }
        __syncthreads();
    }
    const int ntiles_all = (int)((LAS unsigned*)(lds + MB_UN))[8];
    const int tper = (ntiles_all + npieces - 1) / npieces, t_lo = piece * tper, ntiles = min(ntiles_all, t_lo + tper);
    const LAS unsigned short* tl = (const LAS unsigned short*)(lds + MB_TL);
    const bf16* kbase = PG(P, G_MK + h) + (size_t)b * T * HD; const bf16* vbase = PG(P, G_MV + h) + (size_t)b * T * HD;
    v4u pvv[2];
#define MB_LOAD(kp0, bufn) do { _Pragma("unroll") for (int u = 0; u < 2; ++u) { const int p = tid + NTHREADS * u, row = p >> 4, sl = p & 15; \
        __builtin_amdgcn_global_load_lds((const unsigned*)(kbase + (size_t)((kp0) + row) * HD + ((sl ^ (row & 15)) * 8)), (LAS unsigned*)(lds + MB_K0 + (bufn) * 16384 + wave * 1024 + u * 8192), 16, 0, 0); \
        pvv[u] = *(const v4u*)(vbase + (size_t)((kp0) + lane) * HD + (wave + 8 * u) * 8); } } while (0)
#define MB_STORE(buf) do { _Pragma("unroll") for (int u = 0; u < 2; ++u) { \
        const unsigned w4[4] = {pvv[u].x, pvv[u].y, pvv[u].z, pvv[u].w}; const int pcv = wave + 8 * u; \
        _Pragma("unroll") for (int jj = 0; jj < 8; ++jj) *(LAS unsigned short*)(lds + MB_V0 + (buf) * MB_VSZ + (pcv * 8 + jj) * 136 + lane * 2) = (unsigned short)((jj & 1) ? (w4[jj >> 1] >> 16) : (w4[jj >> 1] & 0xffffu)); } } while (0)
    if (t_lo < ntiles) { MB_LOAD((int)tl[t_lo], t_lo & 1); MB_STORE(t_lo & 1); }
    asm volatile("s_waitcnt vmcnt(0)" ::: "memory");
    __syncthreads();
    const f32x2v cA = {0.f, c2}, cB = {2.f * c2, 3.f * c2};
    f32x16 O[4];
#pragma unroll
    for (int et = 0; et < 4; ++et)
#pragma unroll
        for (int r = 0; r < 16; ++r) O[et][r] = 0.f;
    asm volatile("" :: "v"(Qf[0]), "v"(Qf[1]), "v"(Qf[2]), "v"(Qf[3]), "v"(Qf[4]), "v"(Qf[5]), "v"(Qf[6]), "v"(Qf[7]));
    float mrun = -1e30f, lsum = 0.f;
#pragma unroll 1
    for (int ti = t_lo; ti < ntiles; ++ti) {
        const int kp0 = (int)tl[ti], buf = ti & 1;
        { const int tn = (ti + 1 < ntiles) ? ti + 1 : ti; MB_LOAD((int)tl[tn], buf ^ 1); }
        const int blk = kp0 >> 8; const bool isown = (blk == own);
        const bool rowact = isown ? true : (((selmask >> blk) & 1u) != 0u);
        const bool wave_on = isown ? (kp0 <= tq0 + 32 * wave + 31) : (__ballot(rowact) != 0ull);
        if (wave_on) {
            const float moff = (mrun < -1e29f) ? 0.f : mrun;
            f32x16 sc[2];
#pragma unroll
            for (int sub = 0; sub < 2; ++sub) {
#pragma unroll
                for (int r = 0; r < 16; ++r) sc[sub][r] = 0.f;
                const int row = 32 * sub + ql; const LAS unsigned char* kb = lds + MB_K0 + buf * 16384 + row * 256;
#pragma unroll
                for (int ks = 0; ks < 8; ++ks) sc[sub] = MFMA32(*(const LAS bf16x8*)(kb + (((2 * ks + hh) ^ (row & 15)) << 4)), Qf[ks], sc[sub]);
            }
            float mt = NEG;
#pragma unroll
            for (int sub = 0; sub < 2; ++sub) {
                const int kb0 = kp0 + 32 * sub + 4 * hh; const float binit = rowact ? c2 * (float)(kb0 - tq0) - moff : NEG;
#pragma unroll
                for (int j = 0; j < 4; ++j) {
                    const float aj = c2 * (float)(8 * j) + binit; const f32x2v a2 = {aj, aj};
                    f32x2v v01 = (f32x2v){sc[sub][4 * j], sc[sub][4 * j + 1]} + (a2 + cA), v23 = (f32x2v){sc[sub][4 * j + 2], sc[sub][4 * j + 3]} + (a2 + cB);
                    if (isown) { const int kk0 = kb0 + 8 * j; v01.x = (kk0 <= tq) ? v01.x : NEG; v01.y = (kk0 + 1 <= tq) ? v01.y : NEG; v23.x = (kk0 + 2 <= tq) ? v23.x : NEG; v23.y = (kk0 + 3 <= tq) ? v23.y : NEG; }
                    sc[sub][4 * j] = v01.x; sc[sub][4 * j + 1] = v01.y; sc[sub][4 * j + 2] = v23.x; sc[sub][4 * j + 3] = v23.y;
                    mt = fmaxf(mt, v01.x); mt = fmaxf(mt, v01.y); mt = fmaxf(mt, v23.x); mt = fmaxf(mt, v23.y); }
            }
            mt = fmaxf(mt, __shfl_xor(mt, 32));
            if (__any(mt + moff > mrun + 8.0f)) {
                const float mnew = fmaxf(mrun, mt + moff), alpha = __builtin_amdgcn_exp2f(mrun - mnew), dlt = mnew - moff;
#pragma unroll
                for (int et = 0; et < 4; ++et) O[et] = O[et] * alpha;
                lsum *= alpha; mrun = mnew;
#pragma unroll
                for (int sub = 0; sub < 2; ++sub) sc[sub] = sc[sub] - dlt; }
            {   f32x2v pa = {0.f, 0.f}, pb = {0.f, 0.f};
#pragma unroll
                for (int r = 0; r < 16; r += 2) { const float p0 = __builtin_amdgcn_exp2f(sc[0][r]), p1 = __builtin_amdgcn_exp2f(sc[0][r + 1]), p2 = __builtin_amdgcn_exp2f(sc[1][r]), p3 = __builtin_amdgcn_exp2f(sc[1][r + 1]);
                    sc[0][r] = p0; sc[0][r + 1] = p1; sc[1][r] = p2; sc[1][r + 1] = p3; pa += (f32x2v){p0, p1}; pb += (f32x2v){p2, p3}; }
                pa += pb; lsum += pa.x + pa.y; }
            bf16x8 Pb[4];
#pragma unroll
            for (int kk = 0; kk < 4; ++kk) { const int sub = kk >> 1, s2 = kk & 1; v4u pp;
                pp.x = pkbf(sc[sub][8 * s2], sc[sub][8 * s2 + 1]); pp.y = pkbf(sc[sub][8 * s2 + 2], sc[sub][8 * s2 + 3]); pp.z = pkbf(sc[sub][8 * s2 + 4], sc[sub][8 * s2 + 5]); pp.w = pkbf(sc[sub][8 * s2 + 6], sc[sub][8 * s2 + 7]);
                Pb[kk] = __builtin_bit_cast(bf16x8, pp); }
#pragma unroll
            for (int et = 0; et < 4; ++et) { const LAS unsigned char* vb = lds + MB_V0 + buf * MB_VSZ + (32 * et + ql) * 136 + 8 * hh;
#pragma unroll
                for (int kk = 0; kk < 4; ++kk) { const s16x4 lo = *(const volatile LAS s16x4*)(vb + 32 * kk), hi = *(const volatile LAS s16x4*)(vb + 32 * kk + 16);
                    O[et] = MFMA32(__builtin_shufflevector(lo, hi, 0, 1, 2, 3, 4, 5, 6, 7), Pb[kk], O[et]); } }
        }
        if (ti + 1 < ntiles) MB_STORE(buf ^ 1);
        asm volatile("s_waitcnt vmcnt(0)" ::: "memory");
        __syncthreads();
    }
#undef MB_LOAD
#undef MB_STORE
    if (npieces > 1) {
        float* part = (float*)(a.ws + WS_MBP) + (size_t)(slot * 2) * 66 * NTHREADS;
        float* mine = part + (size_t)piece * 66 * NTHREADS + tid;
#pragma unroll
        for (int et = 0; et < 4; ++et)
#pragma unroll
            for (int r = 0; r < 16; ++r) mine[(size_t)(16 * et + r) * NTHREADS] = O[et][r];
        mine[(size_t)64 * NTHREADS] = mrun; mine[(size_t)65 * NTHREADS] = lsum;
        asm volatile("s_waitcnt vmcnt(0)" ::: "memory");
        __syncthreads();
        if (tid == 0) {
            __builtin_amdgcn_fence(__ATOMIC_RELEASE, "agent");
            asm volatile("s_waitcnt vmcnt(0)" ::: "memory");
            const unsigned old = __hip_atomic_fetch_add((unsigned*)(a.ws + WS_CTL) + CW_MBCNT + 128 * l + slot, 1u, __ATOMIC_RELAXED, __HIP_MEMORY_SCOPE_AGENT);
            if (old == (unsigned)(npieces - 1)) { __builtin_amdgcn_fence(__ATOMIC_ACQUIRE, "agent"); asm volatile("s_waitcnt vmcnt(0)" ::: "memory"); }
            ((LAS unsigned*)(lds + MB_UN))[9] = old;
        }
        __syncthreads();
        if (((LAS unsigned*)(lds + MB_UN))[9] != (unsigned)(npieces - 1)) return;
        const float* oth = part + (size_t)(piece ^ 1) * 66 * NTHREADS + tid;
        const float mo = oth[(size_t)64 * NTHREADS], lo = oth[(size_t)65 * NTHREADS];
        const float mm = fmaxf(mrun, mo), fa = __builtin_amdgcn_exp2f(mrun - mm), fb = __builtin_amdgcn_exp2f(mo - mm);
        lsum = lsum * fa + lo * fb;
#pragma unroll
        for (int et = 0; et < 4; ++et) { float ot[16];
#pragma unroll
            for (int r = 0; r < 16; ++r) ot[r] = oth[(size_t)(16 * et + r) * NTHREADS];
#pragma unroll
            for (int r = 0; r < 16; ++r) O[et][r] = O[et][r] * fa + ot[r] * fb; }
    }
    lsum += __shfl_xor(lsum, 32);
    const float inv = 1.0f / lsum;
    uint2 zall[16];
#pragma unroll
    for (int i = 0; i < 16; ++i) zall[i] = *(const uint2*)(PG(P, G_MZ + h) + mrow * HD + 32 * (i >> 2) + 8 * (i & 3) + 4 * hh);
#pragma unroll
    for (int et = 0; et < 4; ++et)
#pragma unroll
        for (int g = 0; g < 4; ++g) { const int e = 32 * et + 8 * g + 4 * hh;
            const uint2 zu = zall[4 * et + g];
            uint2 yo; yo.x = pkbf(O[et][4 * g] * inv * silu_fast(bflo(zu.x)), O[et][4 * g + 1] * inv * silu_fast(bfhi(zu.x)));
            yo.y = pkbf(O[et][4 * g + 2] * inv * silu_fast(bflo(zu.y)), O[et][4 * g + 3] * inv * silu_fast(bfhi(zu.y)));
            *(uint2*)(Y + mrow * DM + 1280 + h * HD + e) = yo; }
}
constexpr int PH_PER_LAYER = 6, N_PHASES = DEPTH * PH_PER_LAYER;
__global__ void __launch_bounds__(NTHREADS, 2) hymba_fwd(Args args) {
    extern __shared__ __attribute__((aligned(16))) unsigned char lds_raw[];
    LAS unsigned char* lds = (LAS unsigned char*)lds_raw;
    {   const int tid0 = threadIdx.x;
        for (int u = tid0; u < (LDS_BYTES - LDSCTL_OFF) / 4; u += NTHREADS) ((LAS unsigned*)(lds + LDSCTL_OFF))[u] = 0u; }
    __syncthreads();
    XcdBarrier bar = xcd_barrier_post((unsigned*)(args.ws + WS_CTL) + CW_BAR, (volatile LAS unsigned*)(lds + MISC_OFF) + 8);
    const int lo = args.ph_lo, hi = args.ph_hi;
#ifndef DUP_PHASE
#define DUP_PHASE -1
#endif
    int dup_done = 0;
#pragma unroll 1
    for (int ph = lo; ph < hi; ++ph) {
        const int l = ph / PH_PER_LAYER, k = ph - l * PH_PER_LAYER;
        Args A = args;
{ size_t zoff = 0; asm volatile("" : "+s"(zoff)); A.ws = args.ws + zoff; A.out = args.out + zoff; }
        int tid = threadIdx.x; asm volatile("" : "+v"(tid));
        const int lane = tid & 63, wave = __builtin_amdgcn_readfirstlane(tid >> 6);
        const int G = gridDim.x; int bx = blockIdx.x; asm volatile("" : "+s"(bx));
        const int vcu = (G % 8 == 0) ? (bx % 8) * (G / 8) + bx / 8 : bx;
        const int gw = vcu * NWAVES + wave, NGW = G * NWAVES;
        const float* xin = (l == 0) ? A.in[0] : A.out;
        switch (k) {
        case 0: { p0_weights(A, l, lds, gw, NGW, wave, lane); p0_rows(A, l, xin, lds, gw, NGW, tid, lane); } break;
        case 1: {
            pg8::Gemm g{(const bf16*)(A.ws + WS_H), (const bf16*)(A.ws + WS_WIN), M, NP, DM}; pg8::StaticOrder S; S.init(M, NP, G, bx);
            pg8::EpiBf16 E{(bf16*)(A.ws + WS_PROJ), 0, 0u};
            pg8::gemm_phase<pg8::EpiBf16, pg8::StaticOrder, true, true>(lds + RING_OFF, g, S, E, tid);
        } break;
        case 2: {
            unsigned* qctr = (unsigned*)(A.ws + WS_CTL) + CW_QUEUE + 64 * l + 16 + 1024 * dup_done;
            __syncthreads();
            if (tid == 0) ((LAS unsigned*)(lds + B_END))[0] = __hip_atomic_fetch_add(qctr, 1u, __ATOMIC_RELAXED, __HIP_MEMORY_SCOPE_AGENT);
            __syncthreads();
            int item = (int)((LAS unsigned*)(lds + B_END))[0];
#pragma unroll 1
            while (item < BATCH * MOBA_NB + BATCH * NSH * NCH) {
                int t2 = threadIdx.x; asm volatile("" : "+v"(t2));
                const int lane2 = t2 & 63, wave2 = __builtin_amdgcn_readfirstlane(t2 >> 6);
                unsigned nxt = 0u;
                if (item < BATCH * MOBA_NB) { mp_item(A, l, item, lds, t2, lane2, wave2); if (t2 == 0) nxt = __hip_atomic_fetch_add(qctr, 1u, __ATOMIC_RELAXED, __HIP_MEMORY_SCOPE_AGENT); }
                else sa_item(A, l, item - BATCH * MOBA_NB, lds, t2, lane2, wave2, qctr, nxt);
                if (t2 == 0) ((LAS unsigned*)(lds + B_END))[0] = nxt;
                __syncthreads();
                item = (int)((LAS unsigned*)(lds + B_END))[0];
            }
        } break;
        case 3: {
            if (bx < 4 * BATCH * GH) {
                const int di = bx >> 2, sh = (di / GH) * NSH + RH + di % GH, seg = (bx >> 1) & 1, nfull = seg ? SB_SPLIT : 0, nend = seg ? NCH : SB_SPLIT;
                sb_item<true>(A, l, sh, bx & 1, nfull, nend, lds, tid, lane, wave);
            } else if (bx < 4 * BATCH * GH + 2 * BATCH * RH) {
                const int ri = (bx - 4 * BATCH * GH) >> 1, sh = (ri / RH) * NSH + ri % RH;
                sb_item<false>(A, l, sh, bx & 1, 0, NCH, lds, tid, lane, wave); }
            unsigned* qctr = (unsigned*)(A.ws + WS_CTL) + CW_QUEUE + 64 * l + 1024 * dup_done;
            for (;;) {
                __syncthreads();
                if (tid == 0) ((LAS unsigned*)(lds + B_END))[0] = __hip_atomic_fetch_add(qctr, 1u, __ATOMIC_RELAXED, __HIP_MEMORY_SCOPE_AGENT);
                __syncthreads();
                const int item = (int)((LAS unsigned*)(lds + B_END))[0];
                if (item >= MB_ITEMS) break;
                int t2 = threadIdx.x; asm volatile("" : "+v"(t2));
                const int lane2 = t2 & 63, wave2 = __builtin_amdgcn_readfirstlane(t2 >> 6);
                mb_item(A, l, item, lds, t2, lane2, wave2);
            }
        } break;
        case 4: fx_rows(A, l, gw, NGW, lane); break;
        default: {
            pg8::Gemm g{(const bf16*)(A.ws + WS_Y), (const bf16*)(A.ws + WS_WOUT), M, DM, DM}; pg8::StaticOrder S; S.init(M, DM, G, bx);
            pg8::EpiResF32 E{A.out, xin, DM};
            pg8::gemm_phase<pg8::EpiResF32, pg8::StaticOrder, true, true>(lds + RING_OFF, g, S, E, tid);
        } break;
        }
        if (DUP_PHASE >= 0 && ph == DUP_PHASE && !dup_done) { dup_done = 1; xcd_barrier(bar); --ph; continue; }
        if (ph + 1 < hi) xcd_barrier(bar);
    }
}

#ifndef RUN_PHASES
#define RUN_PHASES N_PHASES
#endif
#ifndef MK_N_LAUNCHES
#define MK_N_LAUNCHES 1
#endif
extern "C" void kernel_launch(void* const* d_in, const int* in_sizes, int n_in, void* d_out, int out_size, void* d_ws, size_t ws_size, hipStream_t stream) {
    static int grid = 0;
    if (grid == 0) {
        if (n_in != 11 || in_sizes[0] != M * DM || out_size != M * DM || ws_size < WS_END) { fprintf(stderr, "kernel_launch: unexpected shapes (n_in %d, in0 %d, out %d, ws %zu)\n", n_in, n_in > 0 ? in_sizes[0] : -1, out_size, ws_size); grid = -1; return; }
        int dev = 0, cus = 0, per_cu = 0;
        if (hipGetDevice(&dev) != hipSuccess || hipDeviceGetAttribute(&cus, hipDeviceAttributeMultiprocessorCount, dev) != hipSuccess) { grid = -1; return; }
        if (hipFuncSetAttribute((const void*)hymba_fwd, hipFuncAttributeMaxDynamicSharedMemorySize, LDS_BYTES) != hipSuccess) { fprintf(stderr, "kernel_launch: hipFuncSetAttribute failed\n"); grid = -1; return; }
        if (hipOccupancyMaxActiveBlocksPerMultiprocessor(&per_cu, (const void*)hymba_fwd, NTHREADS, LDS_BYTES) != hipSuccess || per_cu < 1) fprintf(stderr, "kernel_launch: occupancy query says %d\n", per_cu);
        (void)hipGetLastError();
        grid = cus;
    }
    if (grid < 0) return;
    (void)hipMemsetAsync((char*)d_ws + WS_CTL, 0, CTL_ZERO_BYTES, stream);
    Args a{};
    for (int i = 0; i < 11; ++i) a.in[i] = (const float*)d_in[i];
    a.out = (float*)d_out; a.ws = (unsigned char*)d_ws;
    constexpr int NL = MK_N_LAUNCHES;
    for (int li = 0; li < NL; ++li) {
        a.ph_lo = (NL == 1) ? 0 : li; a.ph_hi = (NL == 1) ? RUN_PHASES : li + 1;
        hipLaunchKernelGGL(hymba_fwd, dim3(grid), dim3(NTHREADS), LDS_BYTES, stream, a);
    }
}
```

```cpp
#include <hip/hip_runtime.h>
#include <cstdio>
#include <cstdint>
namespace pg8 {
#define PG8_LAS __attribute__((address_space(3)))
typedef unsigned short bf16_t;
typedef short bf16x8 __attribute__((ext_vector_type(8)));
typedef float f32x4 __attribute__((ext_vector_type(4)));
typedef unsigned u32x4 __attribute__((ext_vector_type(4)));
constexpr int BM = 256, BK = 64, HALF = 128, HTB = HALF * BK * 2  , STAGE_BYTES = 8 * HTB, NXCD = 8, WGM = 4;

__host__ __device__ __forceinline__ int lds_byte(int r, int c) { const int st = (r >> 4) * 2 + (c >> 5), rr = r & 15, cc = c & 31, ob = rr * 64 + cc * 2; return st * 1024 + (ob ^ (((ob >> 9) & 1) << 5)); }
__host__ __device__ __forceinline__ void stage_rc(int b, int& R, int& C) { const int st = b / 1024, sb = b % 1024, swz = sb ^ (((sb >> 9) & 1) << 5); R = (st >> 1) * 16 + swz / 64; C = (st & 1) * 32 + (swz % 64) / 2; }
__host__ __device__ __forceinline__ int perm32(int rho) { const int n = rho >> 4, i = rho & 15; return 8 * (i >> 2) + 4 * n + (i & 3); }

struct Unit { int pm, pn; };
struct Gemm { const bf16_t* A; const bf16_t* Bt; int M, N, K; };

struct StaticOrder {
    int nM, nN, nwg, G, c;
    __host__ __device__ void init(int M, int N, int G_, int c_) { nM = M / BM; nN = N / BM; nwg = nM * nN; G = G_; c = c_; }
    __host__ __device__ bool next(int i, Unit& u) const {
        const long L = (long)i * G + c; if (L >= nwg) return false;
        int wgid = (int)L; { const int q = nwg / NXCD, r = nwg % NXCD, xcd = wgid % NXCD, off = wgid / NXCD; wgid = (xcd < r ? xcd * (q + 1) : r * (q + 1) + (xcd - r) * q) + off; }
        const int nig = WGM * nN, gid = wgid / nig, fm = gid * WGM, gsz = (nM - fm) < WGM ? (nM - fm) : WGM;
        u.pm = fm + ((wgid % nig) % gsz); u.pn = (wgid % nig) / gsz; return true;
    }
    __device__ __forceinline__ void a_ready(const Unit&) const {}
    __device__ __forceinline__ void done(const Unit&) const {}
};

__device__ __forceinline__ unsigned cvt_pk_bf16(float lo, float hi) { unsigned r; asm volatile("v_cvt_pk_bf16_f32 %0, %1, %2" : "=v"(r) : "v"(lo), "v"(hi)); return r; }
__device__ __forceinline__ float silu_ep(float x) { return x * __builtin_amdgcn_rcpf(1.f + __builtin_amdgcn_exp2f(-1.4426950408889634f * x)); }
constexpr size_t M_ROWS = 16384;
struct EpiBf16 {
    static constexpr bool PERM = true, AFTER_DRAIN = false;
    bf16_t* O; int ldc; unsigned gate_tiles;
    __device__ __forceinline__ void operator()(const f32x4 (&acc)[2][2][4][2], const Unit& u, int wr, int wc, int fr, int fq) const {
        const int row0 = u.pm * BM + wr * 64 + fr; const int col0 = u.pn * BM + wc * 32 + 8 * fq;
        const bool gate = ((gate_tiles >> u.pn) & 1u) != 0u;
#pragma unroll
        for (int ai = 0; ai < 2; ++ai)
#pragma unroll
            for (int m = 0; m < 4; ++m) { const size_t row = (size_t)(row0 + ai * HALF + m * 16); bf16_t* rowp = O + row * ldc + col0;
#pragma unroll
                for (int bj = 0; bj < 2; ++bj) { f32x4 v0 = acc[ai][bj][m][0], v1 = acc[ai][bj][m][1];
                    if (gate) { v0[0] = silu_ep(v0[0]); v0[1] = silu_ep(v0[1]); v0[2] = silu_ep(v0[2]); v0[3] = silu_ep(v0[3]); v1[0] = silu_ep(v1[0]); v1[1] = silu_ep(v1[1]); v1[2] = silu_ep(v1[2]); v1[3] = silu_ep(v1[3]); }
                    u32x4 w; w.x = cvt_pk_bf16(v0[0], v0[1]); w.y = cvt_pk_bf16(v0[2], v0[3]); w.z = cvt_pk_bf16(v1[0], v1[1]); w.w = cvt_pk_bf16(v1[2], v1[3]);
                    if (ldc) *(u32x4*)(rowp + bj * HALF) = w;
                    else *(u32x4*)(O + ((size_t)(2 * u.pn + bj) * M_ROWS + row) * 128 + wc * 32 + 8 * fq) = w; } }
    }
};
struct EpiResF32 {
    static constexpr bool PERM = false, AFTER_DRAIN = false;
    float* C; const float* R; int ldc;
    __device__ __forceinline__ void operator()(const f32x4 (&acc)[2][2][4][2], const Unit& u, int wr, int wc, int fr, int fq) const {
        const int row0 = u.pm * BM + wr * 64 + fr, col0 = u.pn * BM + wc * 32 + 4 * fq;
#pragma unroll
        for (int ai = 0; ai < 2; ++ai) {
            f32x4 r[4][2][2];
#pragma unroll
            for (int m = 0; m < 4; ++m) { const size_t off = (size_t)(row0 + ai * HALF + m * 16) * ldc + col0;
#pragma unroll
                for (int bj = 0; bj < 2; ++bj)
#pragma unroll
                    for (int n = 0; n < 2; ++n) r[m][bj][n] = *(const f32x4*)(R + off + bj * HALF + n * 16); }
#pragma unroll
            for (int m = 0; m < 4; ++m) { const size_t off = (size_t)(row0 + ai * HALF + m * 16) * ldc + col0;
#pragma unroll
                for (int bj = 0; bj < 2; ++bj)
#pragma unroll
                    for (int n = 0; n < 2; ++n) *(f32x4*)(C + off + bj * HALF + n * 16) = r[m][bj][n] + acc[ai][bj][m][n]; }
        }
    }
};
template <class Epi, class Sched, bool ALIGN_EPI = false, bool SP2 = false>
__device__ __forceinline__ void gemm_phase(PG8_LAS unsigned char* lds, const Gemm g, const Sched& S, const Epi& E, const int tid) {
    const int  wid = __builtin_amdgcn_readfirstlane(tid >> 6), lane = tid & 63, wr = wid >> 2, wc = wid & 3, fr = lane & 15, fq = lane >> 4;
    const int K = g.K, nt = K / BK;
    unsigned voffA[2], voffB[2];
#pragma unroll
    for (int i = 0; i < 2; ++i) { int R, C; stage_rc(tid * 16 + i * 8192, R, C); const int Rb = Epi::PERM ? ((R & ~31) + perm32(R & 31)) : R;
        voffA[i] = (unsigned)(R * K + C) * 2u; voffB[i] = (unsigned)(Rb * K + C) * 2u; }
    const size_t kstep = (size_t)(BK * 2);
    const size_t hstep = (size_t)HALF * K * 2;
    const size_t tstep = 2 * hstep;
    const unsigned ldsw = (unsigned)wid * 1024u;
    const int aoff = lds_byte(wr * 64 + fr, fq * 8), boff = lds_byte(wc * 32 + fr, fq * 8);
#define PG8_SA(b, h) (((b) * 2 + (h)) * HTB)
#define PG8_SB(b, h) ((4 + (b) * 2 + (h)) * HTB)
#define PG8_STAGE(bufoff, gbase, voff) do { _Pragma("unroll") for (int _i = 0; _i < 2; ++_i) \
        __builtin_amdgcn_global_load_lds((const unsigned*)((const char*)(gbase) + (voff)[_i]), (PG8_LAS unsigned*)(lds + (bufoff) + ldsw + _i * 8192), 16, 0, 0); } while (0)
#define PG8_LDA(dst, b, h) do { _Pragma("unroll") for (int m = 0; m < 4; ++m) _Pragma("unroll") for (int k = 0; k < 2; ++k) dst[m][k] = *(const PG8_LAS bf16x8*)(lds + PG8_SA(b, h) + aoff + m * 2048 + k * 1024); } while (0)
#define PG8_LDB(dst, b, h) do { _Pragma("unroll") for (int n = 0; n < 2; ++n) _Pragma("unroll") for (int k = 0; k < 2; ++k) dst[n][k] = *(const PG8_LAS bf16x8*)(lds + PG8_SB(b, h) + boff + n * 2048 + k * 1024); } while (0)
#define PG8_MMA(ai, bj, At, Bt) do { __builtin_amdgcn_s_setprio(1); _Pragma("unroll") for (int m = 0; m < 4; ++m) _Pragma("unroll") for (int n = 0; n < 2; ++n) _Pragma("unroll") for (int k = 0; k < 2; ++k) \
        acc[ai][bj][m][n] = __builtin_amdgcn_mfma_f32_16x16x32_bf16(Bt[n][k], At[m][k], acc[ai][bj][m][n], 0, 0, 0); __builtin_amdgcn_s_setprio(0); } while (0)
#define PG8_WAIT_V(n) asm volatile("s_waitcnt vmcnt(" #n ")" ::: "memory")
#define PG8_WAIT_L(n) asm volatile("s_waitcnt lgkmcnt(" #n ")" ::: "memory")
#define PG8_BAR __builtin_amdgcn_s_barrier()
#define PG8_SCHED __builtin_amdgcn_sched_barrier(0)
    Unit cur, nxt; int ui = 0;
    if (!S.next(0, cur)) return;
    f32x4 acc[2][2][4][2];
#pragma unroll
    for (int a = 0; a < 2; ++a)
#pragma unroll
        for (int b = 0; b < 2; ++b)
#pragma unroll
            for (int m = 0; m < 4; ++m)
#pragma unroll
                for (int n = 0; n < 2; ++n) acc[a][b][m][n] = (f32x4){0.f, 0.f, 0.f, 0.f};
    bf16x8 At[4][2], B0[2][2], B1[2][2];
    const char* cA = (const char*)g.A + (size_t)cur.pm * tstep; const char* cB = (const char*)g.Bt + (size_t)cur.pn * tstep;
    S.a_ready(cur);
    if constexpr (SP2) {
        PG8_STAGE(PG8_SB(0, 0), cB, voffB); PG8_STAGE(PG8_SB(0, 1), cB + hstep, voffB); PG8_STAGE(PG8_SA(0, 0), cA, voffA); PG8_STAGE(PG8_SA(0, 1), cA + hstep, voffA);
        if (wr == 1) PG8_BAR;
        PG8_WAIT_V(2); PG8_BAR;
        PG8_STAGE(PG8_SB(1, 0), cB + kstep, voffB); PG8_STAGE(PG8_SA(1, 0), cA + kstep, voffA); PG8_STAGE(PG8_SB(1, 1), cB + hstep + kstep, voffB);
        PG8_WAIT_V(6); PG8_BAR;
    } else {
        PG8_STAGE(PG8_SB(0, 0), cB, voffB); PG8_STAGE(PG8_SA(0, 0), cA, voffA); PG8_STAGE(PG8_SB(0, 1), cB + hstep, voffB); PG8_STAGE(PG8_SA(0, 1), cA + hstep, voffA);
        if (wr == 1) PG8_BAR;
        PG8_WAIT_V(4); PG8_BAR;
        PG8_STAGE(PG8_SB(1, 0), cB + kstep, voffB); PG8_STAGE(PG8_SA(1, 0), cA + kstep, voffA); PG8_STAGE(PG8_SB(1, 1), cB + hstep + kstep, voffB);
        PG8_WAIT_V(6); PG8_BAR;
    }
    for (;;) {
        const bool has_next = S.next(ui + 1, nxt);
        const char* nA = has_next ? (const char*)g.A + (size_t)nxt.pm * tstep : cA; const char* nB = has_next ? (const char*)g.Bt + (size_t)nxt.pn * tstep : cB;
        for (int t = 0; t < nt; t += 2) {
            const bool last = (t == nt - 2);
            const char* a1 = cA + (size_t)(t + 1) * kstep;
            const char* a2 = last ? nA : cA + (size_t)(t + 2) * kstep; const char* b2 = last ? nB : cB + (size_t)(t + 2) * kstep;
            const char* a3 = a2 + kstep; const char* b3 = b2 + kstep;
            if (last && has_next) S.a_ready(nxt);
            if constexpr (SP2) {
            PG8_LDB(B0, 0, 0); PG8_LDB(B1, 0, 1); PG8_SCHED; PG8_LDA(At, 0, 0); PG8_STAGE(PG8_SA(1, 1), a1 + hstep, voffA);
            PG8_WAIT_V(8); PG8_WAIT_L(0); PG8_BAR; PG8_MMA(0, 0, At, B0); PG8_MMA(0, 1, At, B1); PG8_BAR; PG8_SCHED;
            PG8_LDA(At, 0, 1); PG8_STAGE(PG8_SB(0, 0), b2, voffB); PG8_STAGE(PG8_SB(0, 1), b2 + hstep, voffB); PG8_STAGE(PG8_SA(0, 0), a2, voffA);
            PG8_WAIT_V(8); PG8_WAIT_L(0); PG8_BAR; PG8_MMA(1, 0, At, B0); PG8_MMA(1, 1, At, B1); PG8_BAR; PG8_SCHED;
            PG8_LDB(B0, 1, 0); PG8_LDB(B1, 1, 1); PG8_SCHED; PG8_LDA(At, 1, 0); PG8_STAGE(PG8_SA(0, 1), a2 + hstep, voffA);
            PG8_WAIT_V(8); PG8_WAIT_L(0); PG8_BAR; PG8_MMA(0, 0, At, B0); PG8_MMA(0, 1, At, B1); PG8_BAR; PG8_SCHED;
            PG8_LDA(At, 1, 1); PG8_STAGE(PG8_SB(1, 0), b3, voffB); PG8_STAGE(PG8_SB(1, 1), b3 + hstep, voffB); PG8_STAGE(PG8_SA(1, 0), a3, voffA);
            PG8_WAIT_V(8); PG8_WAIT_L(0); PG8_BAR; PG8_MMA(1, 0, At, B0); PG8_MMA(1, 1, At, B1); PG8_BAR; PG8_SCHED;
            } else {
            PG8_LDB(B0, 0, 0); PG8_SCHED; PG8_LDA(At, 0, 0); PG8_STAGE(PG8_SA(1, 1), a1 + hstep, voffA);
            PG8_WAIT_L(8); PG8_BAR; PG8_WAIT_L(0); PG8_MMA(0, 0, At, B0); PG8_BAR; PG8_SCHED;
            PG8_LDB(B1, 0, 1); PG8_STAGE(PG8_SB(0, 0), b2, voffB);
            PG8_BAR; PG8_WAIT_L(0); PG8_MMA(0, 1, At, B1); PG8_BAR;
            PG8_LDA(At, 0, 1); PG8_STAGE(PG8_SA(0, 0), a2, voffA);
            PG8_BAR; PG8_WAIT_L(0); PG8_MMA(1, 0, At, B0); PG8_BAR; PG8_SCHED;
            PG8_STAGE(PG8_SB(0, 1), b2 + hstep, voffB);
            PG8_WAIT_V(6); PG8_BAR; PG8_MMA(1, 1, At, B1); PG8_BAR;
            PG8_LDB(B0, 1, 0); PG8_SCHED; PG8_LDA(At, 1, 0); PG8_STAGE(PG8_SA(0, 1), a2 + hstep, voffA);
            PG8_WAIT_L(8); PG8_BAR; PG8_WAIT_L(0); PG8_MMA(0, 0, At, B0); PG8_BAR; PG8_SCHED;
            PG8_LDB(B1, 1, 1); PG8_STAGE(PG8_SB(1, 0), b3, voffB);
            PG8_BAR; PG8_WAIT_L(0); PG8_MMA(0, 1, At, B1); PG8_BAR;
            PG8_LDA(At, 1, 1); PG8_STAGE(PG8_SA(1, 0), a3, voffA);
            PG8_BAR; PG8_WAIT_L(0); PG8_MMA(1, 0, At, B0); PG8_BAR; PG8_SCHED;
            PG8_STAGE(PG8_SB(1, 1), b3 + hstep, voffB);
            PG8_WAIT_V(6); PG8_BAR; PG8_MMA(1, 1, At, B1); PG8_BAR;
            }
        }
        if constexpr (ALIGN_EPI) { if (wr == 0) PG8_BAR; }
        if constexpr (!Epi::AFTER_DRAIN) { E(acc, cur, wr, wc, fr, fq); S.done(cur); }
        if (!has_next) break;
#pragma unroll
        for (int a = 0; a < 2; ++a)
#pragma unroll
            for (int b = 0; b < 2; ++b)
#pragma unroll
                for (int m = 0; m < 4; ++m)
#pragma unroll
                    for (int n = 0; n < 2; ++n) acc[a][b][m][n] = (f32x4){0.f, 0.f, 0.f, 0.f};
        cur = nxt; cA = nA; cB = nB; ++ui;
        if constexpr (ALIGN_EPI) { if (wr == 1) PG8_BAR; }
    }
    PG8_WAIT_V(0);
    if constexpr (!ALIGN_EPI) { if (wr == 0) PG8_BAR; }
    PG8_BAR;
    if constexpr (Epi::AFTER_DRAIN) { E.fused(acc, cur, wr, wc, fr, fq, lds, wid, lane); S.done(cur); }
#undef PG8_SA
#undef PG8_SB
#undef PG8_STAGE
#undef PG8_LDA
#undef PG8_LDB
#undef PG8_MMA
#undef PG8_WAIT_V
#undef PG8_WAIT_L
#undef PG8_BAR
#undef PG8_SCHED
}
}
#define GAS __attribute__((address_space(1)))
#define LAS __attribute__((address_space(3)))
typedef unsigned short bf16;
typedef unsigned v4u __attribute__((ext_vector_type(4)));
typedef float f32x4 __attribute__((ext_vector_type(4)));
typedef short bf16x8 __attribute__((ext_vector_type(8)));
typedef GAS unsigned gu32;
typedef GAS unsigned long long gu64;
#define RLX_AGENT __ATOMIC_RELAXED, __HIP_MEMORY_SCOPE_AGENT
#define LDS_WAIT() asm volatile("s_waitcnt lgkmcnt(0)" ::: "memory")
#define VM_WAIT() asm volatile("s_waitcnt vmcnt(0)" ::: "memory")
__device__ __forceinline__ unsigned long long rt() { return __builtin_amdgcn_s_memrealtime(); }
__device__ __forceinline__ unsigned f2bf(float f) { unsigned u = __builtin_bit_cast(unsigned, f); return (u + 0x7fffu + ((u >> 16) & 1u)) >> 16; }
__device__ __forceinline__ unsigned pk2(float lo, float hi) { return f2bf(lo) | (f2bf(hi) << 16); }

#define XB_TMO      128
#define XB_XCNT(j)  (256  + 64 * (j))
#define XB_XSUB(j)  (1280 + 64 * (j))
#define XB_XGEN(j)  (2304 + 64 * (j))
#define XB_TOP      3328
#define XB_TOPGEN   3392
#define XCD_BAR_WORDS 3456
#define XB_SPIN_CAP (1u << 18)

__device__ __forceinline__ unsigned xb_ld(unsigned* p)              { return __hip_atomic_load(p, __ATOMIC_RELAXED, __HIP_MEMORY_SCOPE_AGENT); }
__device__ __forceinline__ unsigned xb_add(unsigned* p, unsigned v) { return __hip_atomic_fetch_add(p, v, __ATOMIC_RELAXED, __HIP_MEMORY_SCOPE_AGENT); }
__device__ __forceinline__ unsigned xb_xcc_id() { return (unsigned)__builtin_amdgcn_s_getreg((3 << 11) | 20) & 0xFu; }
#define XB_SPIN(cond, bar) do { unsigned _sp = 0; while (cond) { __builtin_amdgcn_s_sleep(1); \
    if ((++_sp & 255u) == 0u) { if (xb_ld(&(bar)[XB_TMO])) break; if (_sp > XB_SPIN_CAP) { atomicAdd(&(bar)[XB_TMO], 1u); break; } } } } while (0)

struct XcdBarrier {
    unsigned* bar; unsigned x;
    volatile LAS unsigned* st;
};

__device__ __forceinline__ XcdBarrier xcd_barrier_post(unsigned* bar, volatile LAS unsigned* st) {
    XcdBarrier b; b.bar = bar; b.x = xb_xcc_id(); b.st = st;
    if (threadIdx.x == 0) (void)xb_add(&bar[XB_XCNT(b.x)], 1u);
    return b;
}
__device__ __forceinline__ void xcd_barrier_complete(unsigned* bar, unsigned x, unsigned& nloc, unsigned& nx) {
    const unsigned G = gridDim.x * gridDim.y * gridDim.z;
    unsigned sum, cnt, mine, sp = 0u;
    for (;;) {
        sum = 0u; cnt = 0u; mine = 0u;
#pragma unroll
        for (unsigned j = 0; j < 16; ++j) { const unsigned c = xb_ld(&bar[XB_XCNT(j)]); sum += c; cnt += (c > 0u) ? 1u : 0u; mine = (j == x) ? c : mine; }
        if (sum == G) break;
        __builtin_amdgcn_s_sleep(1);
        if ((++sp & 255u) == 0u) { if (xb_ld(&bar[XB_TMO])) break; if (sp > XB_SPIN_CAP) { atomicAdd(&bar[XB_TMO], 1u); break; } }
    }
    nloc = mine > 0u ? mine : 1u; nx = cnt > 0u ? cnt : 1u;
}

__device__ __forceinline__ void xcd_barrier(const XcdBarrier& b) {
    asm volatile("s_waitcnt vmcnt(0)" ::: "memory");
    __syncthreads();
    if (threadIdx.x == 0) {
        unsigned* bar = b.bar;
        __builtin_amdgcn_s_waitcnt(0);
        unsigned nloc = b.st[0], nx = b.st[1];
        if (nloc == 0u) { xcd_barrier_complete(bar, b.x, nloc, nx); b.st[0] = nloc; b.st[1] = nx; }
        const unsigned old = xb_add(&bar[XB_XSUB(b.x)], 1u);
        const unsigned gen = old / nloc;
        if (old + 1u == (gen + 1u) * nloc) {
            __builtin_amdgcn_fence(__ATOMIC_RELEASE, "agent");
            asm volatile("s_waitcnt vmcnt(0)" ::: "memory");
            const unsigned og = xb_add(&bar[XB_TOP], 1u);
            const unsigned tg = og / nx;
            if (og + 1u == (tg + 1u) * nx) xb_add(&bar[XB_TOPGEN], 1u);
            else XB_SPIN(xb_ld(&bar[XB_TOPGEN]) == tg, bar);
            __builtin_amdgcn_fence(__ATOMIC_ACQUIRE, "agent");
            xb_add(&bar[XB_XGEN(b.x)], 1u);
            asm volatile("s_waitcnt vmcnt(0)" ::: "memory");
        } else {
            XB_SPIN(xb_ld(&bar[XB_XGEN(b.x)]) == gen, bar);
            __builtin_amdgcn_fence(__ATOMIC_ACQUIRE, "agent");
            asm volatile("s_waitcnt vmcnt(0)" ::: "memory");
        }
    }
    __syncthreads();
}

constexpr int NWAVES = 8, NTHREADS = NWAVES * 64;
constexpr int BATCH = 2, T = 8192, DM = 2048, M = BATCH * T, HD = 128, RH = 4, GH = 6, MH = 6, NP = 8192, INW = 8204, DEPTH = 2;
constexpr int C_RQ = 0, C_RK = 512, C_RV = 1024, C_RG = 1536, C_GQ = 2048, C_GK = 2816, C_GV = 3584, C_GZ = 4352, C_MQ = 5120, C_MK = 5888, C_MV = 6656, C_MZ = 7424;
constexpr int NSH = 10;
constexpr float RMS_EPS = 1e-6f;
constexpr int MOBA_BLK = 256, MOBA_NB = T / MOBA_BLK;

constexpr size_t MiB = 1u << 20;
constexpr size_t WS_CTL = 0, CTL_ZERO_BYTES = 1 * MiB;
constexpr size_t WS_WIN = 2 * MiB;
constexpr size_t WS_WOUT = 34 * MiB;
constexpr size_t WS_H = 42 * MiB;
constexpr size_t WS_Y = 42 * MiB;
constexpr size_t WS_GAB = 106 * MiB;
constexpr size_t WS_KMEAN = 107 * MiB;
constexpr size_t WS_PROJ = 108 * MiB;
constexpr size_t WS_GQ = 364 * MiB, WS_GK = 388 * MiB, WS_GV = 412 * MiB, WS_GW = 436 * MiB;
constexpr size_t WS_QKD = 460 * MiB;
constexpr size_t WS_EGS = 480 * MiB;
constexpr size_t WS_ALPHA = 481 * MiB;
constexpr size_t WS_END = 500 * MiB;
constexpr int CW_TMO = 0, CW_CODE = 1, CW_BAR = 4096, CW_QUEUE = 8192, CW_MBCNT = 32768;

constexpr int RING_OFF = 0, RING_BYTES = 131072;
constexpr int QW_OFF = 145408;
constexpr int LDSCTL_OFF = 146432, MISC_OFF = LDSCTL_OFF + 320;
constexpr int LDS_BYTES = 147456;

__device__ __forceinline__ float dpp_f(float v, const int ctrl) { return v; }
#define DPP_ADD(v, ctrl) ((v) + __builtin_bit_cast(float, __builtin_amdgcn_update_dpp(0, __builtin_bit_cast(int, (v)), (ctrl), 0xF, 0xF, true)))
__device__ __forceinline__ float wave_sum(float v) {
    v = DPP_ADD(v, 0xB1);
    v = DPP_ADD(v, 0x4E);
    v = DPP_ADD(v, 0x141);
    v = DPP_ADD(v, 0x140);
    v += __builtin_bit_cast(float, __builtin_amdgcn_update_dpp(0, __builtin_bit_cast(int, v), 0x142, 0xA, 0xF, false));
    v += __builtin_bit_cast(float, __builtin_amdgcn_update_dpp(0, __builtin_bit_cast(int, v), 0x143, 0xC, 0xF, false));
    return __builtin_bit_cast(float, __builtin_amdgcn_readlane(__builtin_bit_cast(int, v), 63));
}
__device__ __forceinline__ float wave_max(float v) {
#pragma unroll
    for (int o = 1; o < 64; o <<= 1) v = fmaxf(v, __shfl_xor(v, o));
    return v;
}
__device__ __forceinline__ float bf2f(unsigned short u) { return __builtin_bit_cast(float, (unsigned)u << 16); }
__device__ __forceinline__ float bflo(unsigned u) { return __builtin_bit_cast(float, u << 16); }
__device__ __forceinline__ float bfhi(unsigned u) { return __builtin_bit_cast(float, u & 0xffff0000u); }
__device__ __forceinline__ float silu_f(float x) { return x / (1.f + expf(-x)); }
__device__ __forceinline__ float silu_fast(float x) { return x * __builtin_amdgcn_rcpf(1.f + __builtin_amdgcn_exp2f(-1.4426950408889634f * x)); }
__device__ __forceinline__ float fexp(float x) { return __builtin_amdgcn_exp2f(1.4426950408889634f * x); }
__device__ __forceinline__ float frsq(float x) { return __builtin_amdgcn_rsqf(x); }

typedef short s16x4 __attribute__((ext_vector_type(4)));
typedef float f32x2v __attribute__((ext_vector_type(2)));
typedef __bf16 bf2v __attribute__((ext_vector_type(2)));
__device__ __forceinline__ unsigned pkbf(float a, float b) { const f32x2v v = {a, b}; const bf2v r = __builtin_convertvector(v, bf2v); return __builtin_bit_cast(unsigned, r); }
__device__ __forceinline__ bf16x8 pack8(const f32x4 a, const f32x4 b) { v4u p; p.x = pkbf(a.x, a.y); p.y = pkbf(a.z, a.w); p.z = pkbf(b.x, b.y); p.w = pkbf(b.z, b.w); return __builtin_bit_cast(bf16x8, p); }
__device__ __forceinline__ bf16x8 ldA2(const LAS unsigned char* p) { const s16x4 lo = *(const volatile LAS s16x4*)p; const s16x4 hi = *(const volatile LAS s16x4*)(p + 32); return __builtin_shufflevector(lo, hi, 0, 1, 2, 3, 4, 5, 6, 7); }
#define MFMA16(a, b, c) __builtin_amdgcn_mfma_f32_16x16x32_bf16((a), (b), (c), 0, 0, 0)
constexpr int NCH = T / 64;
constexpr int SB_SPLIT = 80;

#define PG(P, g) ((P) + (size_t)(g) * M * HD)
constexpr int G_RQ = 0, G_RK = 4, G_RV = 8, G_RG = 12, G_GQ = 16, G_GK = 22, G_GV = 28, G_GZ = 34, G_MQ = 40, G_MK = 46, G_MV = 52, G_MZ = 58;

struct Args { const float* in[11]; float* out; unsigned char* ws; int ph_lo, ph_hi; };

struct TItem { const float* src; bf16* dst; int ldw; };
__device__ __forceinline__ TItem p0_item(const Args& a, int l, int it) {
    constexpr int I_IN = (DM / 64) * (NP / 32);
    TItem t;
    if (it < I_IN) { const int kb = it / (NP / 32), nb = it % (NP / 32), n0 = 32 * nb; const int src = n0 + (n0 >= 5120 ? 12 : 0);
        t.src = a.in[2] + (size_t)l * DM * INW + (size_t)(64 * kb) * INW + src; t.ldw = INW; t.dst = (bf16*)(a.ws + WS_WIN) + (size_t)n0 * DM + 64 * kb; }
    else { const int r = it - I_IN; const int kb = r / (DM / 32), nb = r % (DM / 32), n0 = 32 * nb;
        t.src = a.in[10] + (size_t)l * DM * DM + (size_t)(64 * kb) * DM + n0; t.ldw = DM; t.dst = (bf16*)(a.ws + WS_WOUT) + (size_t)n0 * DM + 64 * kb; }
    return t;
}
__device__ __forceinline__ void p0_weights(const Args& a, int l, LAS unsigned char* lds, int gw, int NGW, int wave, int lane) {
    LAS float* scr = (LAS float*)(lds + RING_OFF + wave * 16384);
    constexpr int NITEMS = (DM / 64) * (NP / 32) + (DM / 64) * (DM / 32);
    f32x4 nv[8]; TItem cur, nxt;
    if (gw < NITEMS) { cur = p0_item(a, l, gw);
#pragma unroll
        for (int i = 0; i < 8; ++i) { const int p = lane + 64 * i; nv[i] = *(const f32x4*)(cur.src + (size_t)(p >> 3) * cur.ldw + 4 * (p & 7)); } }
    for (int it = gw; it < NITEMS; it += NGW) {
        f32x4 v[8];
#pragma unroll
        for (int i = 0; i < 8; ++i) v[i] = nv[i];
        if (it + NGW < NITEMS) { nxt = p0_item(a, l, it + NGW);
#pragma unroll
            for (int i = 0; i < 8; ++i) { const int p = lane + 64 * i; nv[i] = *(const f32x4*)(nxt.src + (size_t)(p >> 3) * nxt.ldw + 4 * (p & 7)); } }
#pragma unroll
        for (int i = 0; i < 8; ++i) { const int p = lane + 64 * i, kk = p >> 3, c4 = p & 7; LAS float* d = scr + kk * 33 + 4 * c4; d[0] = v[i].x; d[1] = v[i].y; d[2] = v[i].z; d[3] = v[i].w; }
        LDS_WAIT(); asm volatile("" ::: "memory");
        const int c = lane & 7;
#pragma unroll
        for (int j = 0; j < 4; ++j) { const int n = (lane >> 3) + 8 * j; const LAS float* s = scr + (8 * c) * 33 + n;
            v4u o; o.x = pkbf(s[0 * 33], s[1 * 33]); o.y = pkbf(s[2 * 33], s[3 * 33]); o.z = pkbf(s[4 * 33], s[5 * 33]); o.w = pkbf(s[6 * 33], s[7 * 33]);
            *(GAS v4u*)(cur.dst + (size_t)n * DM + 8 * c) = o; }
        LDS_WAIT(); asm volatile("" ::: "memory");
        cur = nxt;
    }
}
__device__ __forceinline__ void p0_rows(const Args& a, int l, const float* xin, LAS unsigned char* lds, int gw, int NGW, int tid, int lane) {
    LAS float* wab = (LAS float*)(lds + RING_OFF);
    const float* win = a.in[2] + (size_t)l * DM * INW;
    __syncthreads();
    {
        f32x4 wv[4][3];
#pragma unroll
        for (int r = 0; r < 4; ++r)
#pragma unroll
            for (int q = 0; q < 3; ++q) wv[r][q] = *(const f32x4*)(win + (size_t)(tid + NTHREADS * r) * INW + 5120 + 4 * q);
#pragma unroll
        for (int r = 0; r < 4; ++r)
#pragma unroll
            for (int q = 0; q < 3; ++q) { const int k = tid + NTHREADS * r; wab[(4 * q) * DM + k] = wv[r][q].x; wab[(4 * q + 1) * DM + k] = wv[r][q].y; wab[(4 * q + 2) * DM + k] = wv[r][q].z; wab[(4 * q + 3) * DM + k] = wv[r][q].w; }
    }
    __syncthreads();
    const float* nw = a.in[1] + (size_t)l * DM;
    bf16* H = (bf16*)(a.ws + WS_H); float* GAB = (float*)(a.ws + WS_GAB);
    f32x4 nwv[8];
#pragma unroll
    for (int j = 0; j < 8; ++j) nwv[j] = ((const f32x4*)nw)[lane + 64 * j];
    f32x4 nx[8];
    if (gw < M) {
#pragma unroll
        for (int j = 0; j < 8; ++j) nx[j] = ((const f32x4*)(xin + (size_t)gw * DM) + lane)[64 * j];
    }
    for (int m = gw; m < M; m += NGW) {
        f32x4 v[8]; float ss = 0.f;
#pragma unroll
        for (int j = 0; j < 8; ++j) { v[j] = nx[j]; ss += (v[j].x * v[j].x + v[j].y * v[j].y) + (v[j].z * v[j].z + v[j].w * v[j].w); }
        if (m + NGW < M) {
#pragma unroll
            for (int j = 0; j < 8; ++j) nx[j] = ((const f32x4*)(xin + (size_t)(m + NGW) * DM) + lane)[64 * j];
        }
        ss = wave_sum(ss);
        const float r = 1.0f / sqrtf(ss * (1.f / DM) + RMS_EPS);
        unsigned long long* o8 = (unsigned long long*)(H + (size_t)m * DM) + lane;
#pragma unroll
        for (int j = 0; j < 8; ++j) {
            v[j] = v[j] * r * nwv[j];
            o8[64 * j] = (unsigned long long)pk2(v[j].x, v[j].y) | ((unsigned long long)pk2(v[j].z, v[j].w) << 32);
        }
        float val = 0.f;
#pragma unroll 1
        for (int c = 0; c < 12; ++c) {
            float s = 0.f; f32x4 wv8[8];
#pragma unroll
            for (int j = 0; j < 8; ++j) wv8[j] = *(const LAS f32x4*)(wab + c * DM + 4 * lane + 256 * j);
            __builtin_amdgcn_sched_barrier(0);
#pragma unroll
            for (int j = 0; j < 8; ++j) s += (v[j].x * wv8[j].x + v[j].y * wv8[j].y) + (v[j].z * wv8[j].z + v[j].w * wv8[j].w);
            s = wave_sum(s); val = (lane == c) ? s : val;
        }
        if (lane < 12) {
            float o;
            if (lane < 6) { const float al = a.in[4][l * GH + lane], db = a.in[5][l * GH + lane]; const float z = val + db;
                const float sp = (z > 20.f) ? z : log1pf(expf(z)); o = -expf(al) * sp; }
            else o = 1.f / (1.f + expf(-val));
            GAB[(size_t)m * 12 + lane] = o;
        }
    }
    __syncthreads();
}

constexpr float MB_C1 = 0.12751743074602468f;
__device__ __forceinline__ void mp_item(const Args& a, int l, int item, LAS unsigned char* lds, int tid, int lane, int wave) {
    bf16* P = (bf16*)(a.ws + WS_PROJ);
    const float* qnw = a.in[8] + l * HD; const float* knw = a.in[9] + l * HD;
    const int b = item / MOBA_NB, blk = item - b * MOBA_NB, d0 = 2 * lane;
    const f32x2v qw = *(const f32x2v*)(qnw + d0), kw = *(const f32x2v*)(knw + d0);
    const size_t mbase = (size_t)b * T + (size_t)blk * MOBA_BLK + 32 * wave;
    bf16* base = P + mbase * HD + d0;
    float ks0[MH], ks1[MH];
#pragma unroll
    for (int h = 0; h < MH; ++h) { ks0[h] = 0.f; ks1[h] = 0.f; }
    unsigned cq[MH], ck[MH], nq[MH], nk[MH];
#pragma unroll
    for (int h = 0; h < MH; ++h) { cq[h] = *(const unsigned*)(PG(base, G_MQ + h)); ck[h] = *(const unsigned*)(PG(base, G_MK + h)); }
#pragma unroll 1
    for (int r = 0; r < 32; ++r) {
        bf16* row = base + (size_t)r * HD;
        if (r + 1 < 32) {
#pragma unroll
            for (int h = 0; h < MH; ++h) { nq[h] = *(const unsigned*)(PG(row + HD, G_MQ + h)); nk[h] = *(const unsigned*)(PG(row + HD, G_MK + h)); }
        }
#pragma unroll
        for (int h = 0; h < MH; ++h) {
            const float q0 = bflo(cq[h]), q1 = bfhi(cq[h]), k0 = bflo(ck[h]), k1 = bfhi(ck[h]);
            const float qs = wave_sum(q0 * q0 + q1 * q1), ks = wave_sum(k0 * k0 + k1 * k1);
            const float qr = frsq(qs * (1.f / HD) + RMS_EPS), kr = frsq(ks * (1.f / HD) + RMS_EPS);
            const float kn0 = k0 * kr * kw.x, kn1 = k1 * kr * kw.y;
            *(unsigned*)(PG(row, G_MQ + h)) = pkbf(q0 * qr * qw.x * MB_C1, q1 * qr * qw.y * MB_C1);
            *(unsigned*)(PG(row, G_MK + h)) = pkbf(kn0, kn1);
            ks0[h] += kn0; ks1[h] += kn1;
        }
#pragma unroll
        for (int h = 0; h < MH; ++h) { cq[h] = nq[h]; ck[h] = nk[h]; }
    }
    __syncthreads();
    LAS float* red = (LAS float*)lds;
#pragma unroll
    for (int h = 0; h < MH; ++h) *(LAS f32x2v*)(red + (wave * MH + h) * HD + d0) = (f32x2v){ks0[h], ks1[h]};
    __syncthreads();
    float* KM = (float*)(a.ws + WS_KMEAN);
    for (int i = tid; i < MH * HD; i += NTHREADS) { const int h = i / HD, d = i - h * HD; float sacc = 0.f;
#pragma unroll
        for (int w = 0; w < NWAVES; ++w) sacc += red[(w * MH + h) * HD + d];
        KM[((size_t)(b * MH + h) * MOBA_NB + blk) * HD + d] = sacc * (1.f / MOBA_BLK); }
    __syncthreads();
}
constexpr int SA_QB = 0, SA_KB = 17408, SA_MF = 34816, SA_GC = 52224, SA_BETA = 52480, SA_KT = 52736, SA_VT = 71168, SA_TBB = 89600, SA_TBE = 98816, SA_VB = 108032;
__device__ __forceinline__ void sa_item(const Args& a, int l, int item, LAS unsigned char* lds, int tid, int lane, int wave, unsigned* qctr, unsigned& nxt) {
    const int sh = item / NCH, n = item - sh * NCH, b = sh / NSH, hh = sh - b * NSH;
    const bool delta = hh >= RH; const int h = delta ? hh - RH : hh;
    const int t0 = 64 * n; const size_t m0 = (size_t)b * T + t0;
    const bf16* P = (const bf16*)(a.ws + WS_PROJ); const float* GAB = (const float*)(a.ws + WS_GAB);
    bf16* GQ = (bf16*)(a.ws + WS_GQ); bf16* GK = (bf16*)(a.ws + WS_GK); bf16* GV = (bf16*)(a.ws + WS_GV); bf16* GW = (bf16*)(a.ws + WS_GW);
    const int fr = lane & 15, q4 = lane >> 4, d0 = 2 * lane;
    LAS float* GC = (LAS float*)(lds + SA_GC); LAS float* BETA = (LAS float*)(lds + SA_BETA); LAS float* MF = (LAS float*)(lds + SA_MF);
    const float lng = log1pf(-exp2f(-5.0f - (float)h));
    __syncthreads();
    if (delta) {
        const float* convw = a.in[3] + (size_t)l * 4 * 2304;
        unsigned raw[3][11]; f32x2v cw[3][4];
#pragma unroll
        for (int part = 0; part < 3; ++part) {
            const int c = part * 768 + h * HD + d0; const bf16* pg = PG(P, G_GQ + 6 * part + h) + d0;
#pragma unroll
            for (int j = 0; j < 4; ++j) cw[part][j] = *(const f32x2v*)(convw + j * 2304 + c);
#pragma unroll
            for (int j = 0; j < 11; ++j) { const int tt = t0 + 8 * wave - 3 + j;
                raw[part][j] = (tt >= 0) ? *(const unsigned*)(pg + ((long)m0 + 8 * wave - 3 + j) * HD) : 0u; }
        }
#pragma unroll
        for (int i = 0; i < 8; ++i) {
            const int rr = 8 * wave + i; const size_t m = m0 + rr;
            float o[3][2];
#pragma unroll
            for (int part = 0; part < 3; ++part) { float s0 = 0.f, s1 = 0.f;
#pragma unroll
                for (int j = 0; j < 4; ++j) { s0 += cw[part][j].x * bflo(raw[part][i + j]); s1 += cw[part][j].y * bfhi(raw[part][i + j]); }
                o[part][0] = silu_fast(s0); o[part][1] = silu_fast(s1); }
            const float qs = wave_sum(o[0][0] * o[0][0] + o[0][1] * o[0][1]), ks = wave_sum(o[1][0] * o[1][0] + o[1][1] * o[1][1]);
            const float qr = frsq(qs + RMS_EPS) * 0.08838834764831845f, kr = frsq(ks + RMS_EPS);
            const unsigned qp = pkbf(o[0][0] * qr, o[0][1] * qr), kp = pkbf(o[1][0] * kr, o[1][1] * kr), vp = pkbf(o[2][0], o[2][1]);
            *(unsigned*)(PG(GQ, h) + m * HD + d0) = qp;
            *(LAS unsigned*)(lds + SA_QB + rr * 272 + d0 * 2) = qp; *(LAS unsigned*)(lds + SA_KB + rr * 272 + d0 * 2) = kp; *(LAS unsigned*)(lds + SA_VB + rr * 272 + d0 * 2) = vp;
        }
    } else {
        unsigned rq[8], rk[8];
#pragma unroll
        for (int i = 0; i < 8; ++i) { const size_t mo = (m0 + 8 * wave + i) * HD + d0; rq[i] = *(const unsigned*)(PG(P, G_RQ + h) + mo); rk[i] = *(const unsigned*)(PG(P, G_RK + h) + mo); }
#pragma unroll
        for (int i = 0; i < 8; ++i) { const int rr = 8 * wave + i; *(LAS unsigned*)(lds + SA_QB + rr * 272 + d0 * 2) = rq[i]; *(LAS unsigned*)(lds + SA_KB + rr * 272 + d0 * 2) = rk[i]; }
    }
    if (wave == 7) {
        float g = delta ? GAB[(m0 + lane) * 12 + h] : lng;
#pragma unroll
        for (int o = 1; o < 64; o <<= 1) { const float t = __shfl_up(g, o); if (lane >= o) g += t; }
        GC[lane] = g; BETA[lane] = delta ? GAB[(m0 + lane) * 12 + 6 + h] : 1.0f;
    }
    __syncthreads();
    if (tid == 0) nxt = __hip_atomic_fetch_add(qctr, 1u, __ATOMIC_RELAXED, __HIP_MEMORY_SCOPE_AGENT);
    bf16* QKD = (bf16*)(a.ws + WS_QKD) + ((size_t)sh * NCH + n) * 4096;
    const int ntiles = delta ? 20 : 10;
    for (int p = wave; p < ntiles; p += 8) {
        const bool isqk = p < 10; const int pp = isqk ? p : p - 10;
        const int it = (pp >= 6) ? 3 : (pp >= 3) ? 2 : (pp >= 1) ? 1 : 0, jt = pp - (it * (it + 1)) / 2;
        const LAS unsigned char* Ab = lds + (isqk ? SA_QB : SA_KB) + (16 * it + fr) * 272 + q4 * 16;
        const LAS unsigned char* Bb = lds + SA_KB + (16 * jt + fr) * 272 + q4 * 16;
        f32x4 acc = {0.f, 0.f, 0.f, 0.f};
#pragma unroll
        for (int ks = 0; ks < 4; ++ks) acc = MFMA16(*(const LAS bf16x8*)(Ab + 64 * ks), *(const LAS bf16x8*)(Bb + 64 * ks), acc);
        const int j = 16 * jt + fr; const float gj = GC[j];
#pragma unroll
        for (int r = 0; r < 4; ++r) {
            const int i = 16 * it + 4 * q4 + r; const float gi = GC[i];
            const float dec = fexp(fminf(gi - gj, 0.f));
            if (isqk) { const float val = (i >= j) ? acc[r] * dec * (delta ? 1.0f : 0.08838834764831845f) : 0.f; QKD[i * 64 + j] = (bf16)(pkbf(val, 0.f) & 0xffffu); }
            else { MF[i * 68 + j] = (i > j) ? BETA[i] * acc[r] * dec : 0.f; }
        }
    }
    {
#pragma unroll
        for (int u = 0; u < 2; ++u) { const int pck = wave + 8 * u;
            const v4u kk4 = *(const LAS v4u*)(lds + SA_KB + lane * 272 + pck * 16);
            const unsigned kw[4] = {kk4.x, kk4.y, kk4.z, kk4.w};
#pragma unroll
            for (int jj = 0; jj < 8; ++jj) *(LAS unsigned short*)(lds + SA_KT + (pck * 8 + jj) * 144 + lane * 2) = (unsigned short)((jj & 1) ? (kw[jj >> 1] >> 16) : (kw[jj >> 1] & 0xffffu));
            if (delta) { const v4u vv4 = *(const LAS v4u*)(lds + SA_VB + lane * 272 + pck * 16); const unsigned vw[4] = {vv4.x, vv4.y, vv4.z, vv4.w};
#pragma unroll
                for (int jj = 0; jj < 8; ++jj) *(LAS unsigned short*)(lds + SA_VT + (pck * 8 + jj) * 144 + lane * 2) = (unsigned short)((jj & 1) ? (vw[jj >> 1] >> 16) : (vw[jj >> 1] & 0xffffu)); } }
    }
    for (int idx = tid; idx < 6 * 256; idx += NTHREADS) {
        const int u = idx >> 8, e = idx & 255; const int it = (u < 3) ? 0 : (u < 5) ? 1 : 2, jt = (u < 3) ? u + 1 : (u < 5) ? u - 1 : 3;
        QKD[(16 * it + (e >> 4)) * 64 + 16 * jt + (e & 15)] = 0;
        if (delta) MF[(16 * it + (e >> 4)) * 68 + 16 * jt + (e & 15)] = 0.f;
    }
    __syncthreads();
    {
        bf16* ktd = (delta ? PG(GK, h) : PG((bf16*)(a.ws + WS_PROJ), G_RK + h)) + m0 * HD;
#pragma unroll
        for (int u = 0; u < 2; ++u) { const int p = tid + NTHREADS * u, d = p >> 3, pc = p & 7; *(v4u*)(ktd + d * 64 + pc * 8) = *(const LAS v4u*)(lds + SA_KT + d * 144 + pc * 16); }
    }
    if (delta) {
        const int bh6 = b * GH + h;
        if (wave == 0) {
            {
                const int ab = lane >> 4, cc = lane & 15;
                LAS float* mb = MF + (16 * ab) * 68 + 16 * ab;
                float Td[16];
#pragma unroll
                for (int r = 0; r < 16; ++r) {
                    f32x4 mr[4];
#pragma unroll
                    for (int j4 = 0; j4 < (r + 3) / 4; ++j4) mr[j4] = *(const LAS f32x4*)(mb + r * 68 + 4 * j4);
                    __builtin_amdgcn_sched_barrier(0);
                    float a0 = (cc == r) ? 1.f : 0.f, a1 = 0.f;
#pragma unroll
                    for (int j = 0; j < r; ++j) { if (j & 1) a1 -= mr[j >> 2][j & 3] * Td[j]; else a0 -= mr[j >> 2][j & 3] * Td[j]; }
                    Td[r] = a0 + a1;
                    __builtin_amdgcn_sched_barrier(0);
                }
#pragma unroll
                for (int r = 0; r < 16; ++r) mb[r * 68 + cc] = Td[r];
            }
            LDS_WAIT(); asm volatile("" ::: "memory");
#pragma unroll
            for (int ar = 1; ar < 4; ++ar) {
                f32x4 Rt[3];
#pragma unroll
                for (int nb = 0; nb < ar; ++nb) {
                    f32x4 acc = {0.f, 0.f, 0.f, 0.f};
#pragma unroll
                    for (int ks = 0; ks < (ar + 1) / 2; ++ks) {
                        const int k0 = 32 * ks + 8 * q4;
                        f32x4 l0 = *(const LAS f32x4*)(MF + (16 * ar + fr) * 68 + k0), l1 = *(const LAS f32x4*)(MF + (16 * ar + fr) * 68 + k0 + 4);
                        if (k0 >= 16 * ar) { l0 = (f32x4){0.f, 0.f, 0.f, 0.f}; l1 = l0; }
                        f32x4 t0 = {MF[(k0 + 0) * 68 + 16 * nb + fr], MF[(k0 + 1) * 68 + 16 * nb + fr], MF[(k0 + 2) * 68 + 16 * nb + fr], MF[(k0 + 3) * 68 + 16 * nb + fr]};
                        f32x4 t1 = {MF[(k0 + 4) * 68 + 16 * nb + fr], MF[(k0 + 5) * 68 + 16 * nb + fr], MF[(k0 + 6) * 68 + 16 * nb + fr], MF[(k0 + 7) * 68 + 16 * nb + fr]};
                        acc = MFMA16(pack8(l0, l1), pack8(t0, t1), acc);
                    }
                    Rt[nb] = acc;
                }
                const f32x4 td = *(const LAS f32x4*)(MF + (16 * ar + fr) * 68 + 16 * ar + 4 * q4);
                const f32x4 z4 = {0.f, 0.f, 0.f, 0.f};
                const bf16x8 ta = pack8(td, z4);
#pragma unroll
                for (int nb = 0; nb < ar; ++nb) {
                    const f32x4 tn = MFMA16(ta, pack8(Rt[nb], z4), z4);
#pragma unroll
                    for (int r = 0; r < 4; ++r) MF[(16 * ar + 4 * q4 + r) * 68 + 16 * nb + fr] = -tn[r];
                }
                LDS_WAIT(); asm volatile("" ::: "memory");
            }
        } else if (wave == 1) {
            float* EGS = (float*)(a.ws + WS_EGS) + ((size_t)bh6 * T + t0 + lane) * 2;
            const float gl = GC[63], gi = GC[lane];
            EGS[0] = fexp(gi); EGS[1] = fexp(gl - gi);
            if (lane == 0) ((float*)(a.ws + WS_ALPHA))[bh6 * NCH + n] = fexp(gl);
        }
        __syncthreads();
        {
            const int row = tid >> 3, c0 = (tid & 7) * 8;
            const f32x4 t0v = *(const LAS f32x4*)(MF + row * 68 + c0), t1v = *(const LAS f32x4*)(MF + row * 68 + c0 + 4);
            const f32x4 b0 = *(const LAS f32x4*)(BETA + c0), b1 = *(const LAS f32x4*)(BETA + c0 + 4);
            const f32x4 g0 = *(const LAS f32x4*)(GC + c0), g1 = *(const LAS f32x4*)(GC + c0 + 4);
            const f32x4 x0 = t0v * b0, x1 = t1v * b1;
            const f32x4 e0v = {fexp(g0.x), fexp(g0.y), fexp(g0.z), fexp(g0.w)}, e1v = {fexp(g1.x), fexp(g1.y), fexp(g1.z), fexp(g1.w)};
            *(LAS bf16x8*)(lds + SA_TBB + row * 144 + c0 * 2) = pack8(x0, x1);
            *(LAS bf16x8*)(lds + SA_TBE + row * 144 + c0 * 2) = pack8(x0 * e0v, x1 * e1v);
        }
        __syncthreads();
#pragma unroll
        for (int which = 0; which < 2; ++which) {
            const LAS unsigned char* Ab = lds + (which ? SA_VT : SA_KT) + (16 * wave + fr) * 144 + q4 * 16;
            bf16* dst = PG(which ? GV : GW, h) + m0 * HD + 16 * wave + 4 * q4;
#pragma unroll
            for (int it = 0; it < 4; ++it) {
                const LAS unsigned char* Bb = lds + (which ? SA_TBB : SA_TBE) + (16 * it + fr) * 144 + q4 * 16;
                f32x4 acc = {0.f, 0.f, 0.f, 0.f};
#pragma unroll
                for (int ks = 0; ks < 2; ++ks) acc = MFMA16(*(const LAS bf16x8*)(Ab + 64 * ks), *(const LAS bf16x8*)(Bb + 64 * ks), acc);
                uint2 o; o.x = pkbf(acc[0], acc[1]); o.y = pkbf(acc[2], acc[3]);
                *(uint2*)(dst + (size_t)(16 * it + fr) * HD) = o;
            }
        }
    }
    __syncthreads();
}

constexpr int B_KB = 0, B_QB = 17408, B_KT = 34816, B_QD = 53248, B_V = 62464, B_EG = 71680, B_BUF = 72704;
constexpr int B_END = QW_OFF;
#define SCHED_FENCE() __builtin_amdgcn_sched_barrier(0)
template <bool DELTA, bool FULL>
__device__ __forceinline__ void sb_chunk(f32x4 (&S)[8], const LAS unsigned char* lds, const LAS unsigned char* a272, const LAS unsigned char* a144, const LAS unsigned char* vcol, const LAS float* EG, int q4, bf16* ybase) {
    constexpr bool delta = DELTA;
        {
        bf16x8 Sb[4];
#pragma unroll
        for (int s = 0; s < 4; ++s) Sb[s] = pack8(S[2 * s], S[2 * s + 1]);
        bf16x8 fk[4], fq[4], gk[4], gq[4];
        unsigned short vr[16]; f32x4 egv[4];
#pragma unroll
        for (int it = 0; it < 4; ++it) { egv[it] = *(const LAS f32x4*)(EG + 16 * it + 4 * q4);
#pragma unroll
            for (int r = 0; r < 4; ++r) vr[4 * it + r] = *(const LAS unsigned short*)(vcol + (16 * it + r) * 144); }
#pragma unroll
        for (int s = 0; s < 4; ++s) { if (delta) fk[s] = ldA2(a272 + B_KB + 64 * s); if (FULL) fq[s] = ldA2(a272 + B_QB + 64 * s); }
        SCHED_FENCE();
        f32x4 R[4], qs[4];
#define SB_KQ(it, FK, FQ, NK, NQ) do { \
            if ((it) < 3) { _Pragma("unroll") for (int s = 0; s < 4; ++s) { if (delta) NK[s] = ldA2(a272 + B_KB + (16 * ((it) + 1)) * 272 + 64 * s); if (FULL) NQ[s] = ldA2(a272 + B_QB + (16 * ((it) + 1)) * 272 + 64 * s); } } \
            f32x4 ks = {0.f, 0.f, 0.f, 0.f}; qs[it] = (f32x4){0.f, 0.f, 0.f, 0.f}; \
            _Pragma("unroll") for (int s = 0; s < 4; ++s) { if (delta) ks = MFMA16(FK[s], Sb[s], ks); if (FULL) qs[it] = MFMA16(FQ[s], Sb[s], qs[it]); } \
            _Pragma("unroll") for (int r = 0; r < 4; ++r) { const float v = bf2f(vr[4 * (it) + r]); R[it][r] = delta ? v - ks[r] : v; } \
            qs[it] = qs[it] * egv[it]; \
            SCHED_FENCE(); } while (0)
        SB_KQ(0, fk, fq, gk, gq); SB_KQ(1, gk, gq, fk, fq); SB_KQ(2, fk, fq, gk, gq);
        bf16x8 fd[8];
#pragma unroll
        for (int i = 0; i < 8; ++i) { if (FULL) fd[i] = ldA2(a144 + B_QD + (16 * (i >> 1)) * 144 + 64 * (i & 1)); }
        SB_KQ(3, gk, gq, fk, fq);
#undef SB_KQ
        bf16x8 Rb[2];
#pragma unroll
        for (int s = 0; s < 2; ++s) Rb[s] = pack8(R[2 * s], R[2 * s + 1]);
        f32x4 vn[4]; bf16x8 VNb[2];
#pragma unroll
        for (int it = 0; it < 4; ++it) vn[it] = R[it];
        VNb[0] = Rb[0]; VNb[1] = Rb[1];
        bf16x8 VSb[2];
#pragma unroll
        for (int s = 0; s < 2; ++s) { const f32x4 g0 = *(const LAS f32x4*)(EG + 64 + 32 * s + 4 * q4), g1 = *(const LAS f32x4*)(EG + 64 + 32 * s + 16 + 4 * q4); VSb[s] = pack8(g0 * vn[2 * s], g1 * vn[2 * s + 1]); }
        const float alpha = EG[128];
        bf16x8 fs[8];
#pragma unroll
        for (int i = 0; i < 8; ++i) fs[i] = ldA2(a144 + B_KT + (16 * (i >> 1)) * 144 + 64 * (i & 1));
        if (FULL) {
#pragma unroll
        for (int it = 0; it < 4; ++it) { f32x4 o = qs[it];
#pragma unroll
            for (int s = 0; s < 2; ++s) o = MFMA16(fd[2 * it + s], VNb[s], o);
            bf16* yp = ybase + (size_t)(16 * it) * DM;
            const unsigned o01 = pkbf(o[0], o[1]), o23 = pkbf(o[2], o[3]);
            yp[0] = (bf16)(o01 & 0xffffu); yp[DM] = (bf16)(o01 >> 16); yp[2 * DM] = (bf16)(o23 & 0xffffu); yp[3 * DM] = (bf16)(o23 >> 16); }
        }
        SCHED_FENCE();
        bf16x8 fs2[8];
#pragma unroll
        for (int i = 0; i < 8; ++i) fs2[i] = ldA2(a144 + B_KT + (16 * (4 + (i >> 1))) * 144 + 64 * (i & 1));
#pragma unroll
        for (int dt = 0; dt < 4; ++dt) { S[dt] = S[dt] * alpha;
#pragma unroll
            for (int s = 0; s < 2; ++s) S[dt] = MFMA16(fs[2 * dt + s], VSb[s], S[dt]); }
        SCHED_FENCE();
#pragma unroll
        for (int dt = 4; dt < 8; ++dt) { S[dt] = S[dt] * alpha;
#pragma unroll
            for (int s = 0; s < 2; ++s) S[dt] = MFMA16(fs2[2 * (dt - 4) + s], VSb[s], S[dt]); }
        }
}
#undef SCHED_FENCE

template <bool DELTA>
__device__ __forceinline__ void sb_item(const Args& a, int l, int sh, int half, int nfull, int nend, LAS unsigned char* lds, int tid, int lane, int wave) {
    const int b = sh / NSH, hh = sh - b * NSH; constexpr bool delta = DELTA; const int h = delta ? hh - RH : hh, bh6 = b * GH + h;
    const bf16* P = (const bf16*)(a.ws + WS_PROJ); bf16* Y = (bf16*)(a.ws + WS_Y);
    const bf16* qg = delta ? PG((const bf16*)(a.ws + WS_GQ), h) : PG(P, G_RQ + h);
    const bf16* kg = delta ? PG((const bf16*)(a.ws + WS_GK), h) : PG(P, G_RK + h);
    const bf16* vg = delta ? PG((const bf16*)(a.ws + WS_GV), h) : PG(P, G_RV + h);
    constexpr size_t ld = HD; const size_t m0 = (size_t)b * T;
    const bf16* wg = PG((const bf16*)(a.ws + WS_GW), h); const bf16* QDp = (const bf16*)(a.ws + WS_QKD) + (size_t)sh * NCH * 4096;
    const float* EGS = (const float*)(a.ws + WS_EGS) + (size_t)bh6 * T * 2; const float* ALPHA = (const float*)(a.ws + WS_ALPHA) + bh6 * NCH;
    const int gcol = delta ? C_GZ + h * HD : C_RG + h * HD, ycol = delta ? 512 + h * HD : h * HD;
    const float* nw = delta ? a.in[7] + (size_t)l * HD : a.in[6] + ((size_t)l * RH + h) * HD;
    const int fr = lane & 15, q4 = lane >> 4, e0 = 64 * half + 16 * (wave & 3);
    const bool cw = wave < 4;
    struct PF { v4u pk[4], pw[4], pq[4], pv[2], pd[2]; float peg; };
    PF fa, fb;
    const int ht = tid - 256, hw = wave - 4;
#define SB_LOAD(F, nn) do { \
        _Pragma("unroll") for (int u = 0; u < 4; ++u) { \
            F.pk[u] = *(const v4u*)(kg + (m0 + 64 * (nn)) * ld + (ht + 256 * u) * 8); \
            const int p = ht + 256 * u, row = p >> 4, pc = p & 15; \
            F.pq[u] = *(const v4u*)(qg + (m0 + 64 * (nn) + row) * ld + pc * 8); \
            if (delta) F.pw[u] = *(const v4u*)(wg + (m0 + 64 * (nn) + row) * ld + pc * 8); } \
        _Pragma("unroll") for (int u = 0; u < 2; ++u) { const int p = ht + 256 * u; const size_t off = (size_t)(nn) * 4096 + (p >> 3) * 64 + (p & 7) * 8; F.pd[u] = *(const v4u*)(QDp + off); \
            F.pv[u] = *(const v4u*)(vg + (m0 + 64 * (nn) + (p >> 3)) * ld + 64 * half + (p & 7) * 8); } \
        if (delta) { const float* pp = (ht < 128) ? EGS + (64 * (nn) + (ht & 63)) * 2 + (ht >> 6) : ALPHA + (nn); F.peg = *pp; } \
    } while (0)
#define SB_STORE(F, BO, WQ) do {        \
        _Pragma("unroll") for (int u = 0; u < 4; ++u) { \
            const int p = ht + 256 * u, row = p >> 4, pc = p & 15; \
            *(LAS v4u*)(lds + (BO) + B_KT + (p >> 3) * 144 + (p & 7) * 16) = F.pk[u]; \
            if (delta) *(LAS v4u*)(lds + (BO) + B_KB + row * 272 + pc * 16) = F.pw[u]; } \
        _Pragma("unroll") for (int u = 0; u < 2; ++u) { const int p = ht + 256 * u, row = p >> 3, pc = p & 7; *(LAS v4u*)(lds + (BO) + B_V + row * 144 + pc * 16) = F.pv[u]; } \
        if (WQ) { \
            _Pragma("unroll") for (int u = 0; u < 4; ++u) { const int p = ht + 256 * u, row = p >> 4, pc = p & 15; *(LAS v4u*)(lds + (BO) + B_QB + row * 272 + pc * 16) = F.pq[u]; } \
            _Pragma("unroll") for (int u = 0; u < 2; ++u) { const int p = ht + 256 * u, row = p >> 3, pc = p & 7; *(LAS v4u*)(lds + (BO) + B_QD + row * 144 + pc * 16) = F.pd[u]; } } \
        if (delta && ht < 129) ((LAS float*)(lds + (BO) + B_EG))[ht] = F.peg; \
    } while (0)
    __syncthreads();
    if (!delta) {
        const float lng = log1pf(-exp2f(-5.0f - (float)h));
        float ev = 0.f;
        if (tid < 64) ev = expf((float)(tid + 1) * lng);
        else if (tid < 128) ev = 0.08838834764831845f * expf((float)(127 - tid) * lng);
        else if (tid == 128) ev = expf(64.f * lng);
        if (tid < 129) { ((LAS float*)(lds + B_EG))[tid] = ev; ((LAS float*)(lds + B_BUF + B_EG))[tid] = ev; }
    }
    if (!cw) { SB_LOAD(fa, 0); SB_STORE(fa, 0, nfull == 0); SB_LOAD(fa, 1); { const int nl = (2 < nend) ? 2 : nend - 1; SB_LOAD(fb, nl); } }
    __syncthreads();
    f32x4 S[8];
#pragma unroll
    for (int dt = 0; dt < 8; ++dt) S[dt] = (f32x4){0.f, 0.f, 0.f, 0.f};
    const int o272 = fr * 272 + 8 * q4, o144 = fr * 144 + 8 * q4, ovc = B_V + (4 * q4) * 144 + (16 * (wave & 3) + fr) * 2;
#define SCHED_FENCE() __builtin_amdgcn_sched_barrier(0)
    if (!cw) {
#pragma unroll 1
        for (int n2 = 0; n2 < nend; n2 += 2) {
            SB_STORE(fa, B_BUF, n2 + 1 >= nfull);
            { const int nl = (n2 + 3 < nend) ? n2 + 3 : nend - 1; SB_LOAD(fa, nl); }
            __syncthreads();
            SB_STORE(fb, 0, n2 + 2 >= nfull);
            { const int nl = (n2 + 4 < nend) ? n2 + 4 : nend - 1; SB_LOAD(fb, nl); }
            __syncthreads();
        }
    } else {
    bf16* yb0 = Y + (m0 + 4 * q4) * DM + ycol + e0 + fr;
#pragma unroll 1
    for (int n = 0; n < nfull; ++n) {
        const LAS unsigned char* bb = lds + (n & 1) * B_BUF;
        sb_chunk<DELTA, false>(S, lds, bb + o272, bb + o144, bb + ovc, (const LAS float*)(bb + B_EG), q4, yb0);
        __syncthreads();
    }
#pragma unroll 1
    for (int n = nfull; n < nend; ++n) {
        const LAS unsigned char* bb = lds + (n & 1) * B_BUF;
        sb_chunk<DELTA, true>(S, lds, bb + o272, bb + o144, bb + ovc, (const LAS float*)(bb + B_EG), q4, yb0 + (size_t)(64 * n) * DM);
        __syncthreads();
    }
    }
#undef SCHED_FENCE
#undef SB_LOAD
#undef SB_STORE
}
__device__ __forceinline__ void fx_rows(const Args& a, int l, int gw, int NGW, int lane) {
    const bf16* P = (const bf16*)(a.ws + WS_PROJ); bf16* Y = (bf16*)(a.ws + WS_Y);
    const float* rnw = a.in[6] + (size_t)l * RH * HD; const float* gnw = a.in[7] + (size_t)l * HD;
    const int d0 = 2 * lane;
    f32x2v wr[RH];
#pragma unroll
    for (int h = 0; h < RH; ++h) wr[h] = *(const f32x2v*)(rnw + h * HD + d0);
    const f32x2v wg = *(const f32x2v*)(gnw + d0);
    for (int m = gw; m < M; m += NGW) {
        unsigned ou[NSH], zu[NSH];
#pragma unroll
        for (int hh = 0; hh < NSH; ++hh) { ou[hh] = *(const unsigned*)(Y + (size_t)m * DM + hh * HD + d0);
            zu[hh] = *(const unsigned*)(PG(P, (hh < RH) ? (G_RG + hh) : (G_GZ + hh - RH)) + (size_t)m * HD + d0); }
#pragma unroll
        for (int hh = 0; hh < NSH; ++hh) {
            const float ox = bflo(ou[hh]), oy = bfhi(ou[hh]);
            const float rs = __builtin_amdgcn_rsqf(wave_sum(ox * ox + oy * oy) * (1.f / HD) + RMS_EPS);
            const f32x2v w = (hh < RH) ? wr[hh < RH ? hh : 0] : wg;
            *(unsigned*)(Y + (size_t)m * DM + hh * HD + d0) = pkbf(ox * rs * w.x * silu_fast(bflo(zu[hh])), oy * rs * w.y * silu_fast(bfhi(zu[hh])));
        }
    }
}

typedef float f32x16 __attribute__((ext_vector_type(16)));
#define MFMA32(a, b, c) __builtin_amdgcn_mfma_f32_32x32x16_bf16((a), (b), (c), 0, 0, 0)
constexpr int MB_KM = 0, MB_K0 = 16384, MB_V0 = 49152, MB_VSZ = 17408, MB_TL = 83968, MB_UN = 84480, MB_END = 84608;
constexpr int MB_ENTRIES = 224, MB_ITEMS = BATCH * MB_ENTRIES, MB_SLOTS = 32;
__device__ const unsigned short mb_order[MB_ENTRIES] = {32509, 32765, 124, 125, 30453, 30709, 28397, 28653, 116, 117, 31484, 31740, 29428, 29684, 27372, 27628, 25316, 25572, 26341, 26597, 23260, 23516, 24285, 24541, 108, 109, 21204, 21460, 22229, 22485, 19148, 19404, 20173, 20429, 100, 101, 17092, 17348, 18117, 18373, 251, 243, 235, 227, 219, 211, 203, 195, 187, 15036, 15292, 16061, 16317, 179, 171, 163, 155, 147, 139, 131, 123, 115, 107, 99, 91, 92, 93, 12980, 13236, 14005, 14261, 10924, 11180, 11949, 12205, 83, 84, 85, 8868, 9124, 9893, 10149, 6812, 7068, 7837, 8093, 75, 76, 77, 4756, 5012, 5781, 6037, 2700, 2956, 3725, 3981, 67, 68, 69, 644, 900, 1669, 1925, 59, 60, 61, 51, 52, 53, 250, 242, 234, 226, 218, 210, 202, 194, 186, 178, 170, 162, 154, 146, 138, 130, 122, 114, 106, 98, 90, 82, 74, 66, 58, 50, 42, 43, 44, 45, 34, 35, 36, 37, 26, 27, 28, 29, 249, 241, 233, 225, 217, 209, 201, 193, 185, 177, 169, 161, 153, 145, 137, 129, 121, 113, 105, 97, 89, 81, 73, 65, 57, 49, 41, 33, 25, 17, 18, 19, 20, 21, 248, 240, 232, 224, 216, 208, 200, 192, 184, 176, 168, 160, 152, 144, 136, 128, 120, 112, 104, 96, 88, 80, 72, 64, 56, 48, 40, 32, 24, 16, 8, 9, 10, 11, 12, 13, 0, 1, 2, 3, 4, 5};
constexpr size_t WS_MBP = 482 * MiB;
__device__ __forceinline__ void mb_item(const Args& a, int l, int item, LAS unsigned char* lds, int tid, int lane, int wave) {
    const int oe = (int)mb_order[item >> 1], qb = (oe >> 3) & 31, h = oe & 7, piece = (oe >> 8) & 1, npieces = ((oe >> 9) & 1) + 1, slot = (oe >> 10) + MB_SLOTS * (item & 1), b = item & 1, bh = b * MH + h, own = qb;
    const bf16* P = (const bf16*)(a.ws + WS_PROJ); bf16* Y = (bf16*)(a.ws + WS_Y);
    const int ql = lane & 31, hh = lane >> 5;
    const int tq0 = MOBA_BLK * qb, tq = tq0 + 32 * wave + ql;
    const size_t mrow = (size_t)b * T + tq;
    const float NEG = -__builtin_inff();
    const float c2v = exp2f(-8.0f * (float)(h + 1) / (float)MH) * 1.4426950408889634f;
    const float c2 = __builtin_bit_cast(float, __builtin_amdgcn_readfirstlane(__builtin_bit_cast(int, c2v)));
    const int reach = (int)((100.0f / c2 - 1.0f) * (1.0f / MOBA_BLK)) + 1;
    bf16x8 Qf[8];
#pragma unroll
    for (int ks = 0; ks < 8; ++ks) Qf[ks] = *(const bf16x8*)(PG(P, G_MQ + h) + mrow * HD + 16 * ks + 8 * hh);
    __syncthreads();
    { const float* KM = (const float*)(a.ws + WS_KMEAN) + (size_t)bh * MOBA_NB * HD; LAS float* km = (LAS float*)(lds + MB_KM);
      for (int i = tid; i < MOBA_NB * HD / 4; i += NTHREADS) ((LAS f32x4*)km)[i] = ((const f32x4*)KM)[i]; }
    __syncthreads();
    unsigned selmask = 0u;
    {
        float qf[64];
#pragma unroll
        for (int ks = 0; ks < 8; ++ks) { const v4u u = __builtin_bit_cast(v4u, Qf[ks]);
            qf[8 * ks] = bflo(u.x); qf[8 * ks + 1] = bfhi(u.x); qf[8 * ks + 2] = bflo(u.y); qf[8 * ks + 3] = bfhi(u.y); qf[8 * ks + 4] = bflo(u.z); qf[8 * ks + 5] = bfhi(u.z); qf[8 * ks + 6] = bflo(u.w); qf[8 * ks + 7] = bfhi(u.w); }
        float v1 = NEG, v2 = NEG, v3 = NEG; int i1 = 0, i2 = 0, i3 = 0;
#pragma unroll 1
        for (int n = 0; n < own; ++n) {
            const LAS float* kr = (const LAS float*)(lds + MB_KM) + n * HD + 8 * hh;
            float g0 = 0.f, g1 = 0.f;
#pragma unroll
            for (int ks = 0; ks < 8; ++ks) { const f32x4 ka = *(const LAS f32x4*)(kr + 16 * ks), kb = *(const LAS f32x4*)(kr + 16 * ks + 4);
                g0 += (qf[8 * ks] * ka.x + qf[8 * ks + 1] * ka.y) + (qf[8 * ks + 2] * ka.z + qf[8 * ks + 3] * ka.w);
                g1 += (qf[8 * ks + 4] * kb.x + qf[8 * ks + 5] * kb.y) + (qf[8 * ks + 6] * kb.z + qf[8 * ks + 7] * kb.w); }
            float g = g0 + g1; g += __shfl_xor(g, 32);
            if (g > v1) { v3 = v2; i3 = i2; v2 = v1; i2 = i1; v1 = g; i1 = n; }
            else if (g > v2) { v3 = v2; i3 = i2; v2 = g; i2 = n; }
            else if (g > v3) { v3 = g; i3 = n; }
        }
        if (v1 > NEG) selmask |= 1u << i1;
        if (v2 > NEG) selmask |= 1u << i2;
        if (v3 > NEG) selmask |= 1u << i3;
    }
    {
        unsigned u = selmask;
#pragma unroll
        for (int o = 1; o < 64; o <<= 1) u |= __shfl_xor(u, o);
        if (lane == 0) ((LAS unsigned*)(lds + MB_UN))[wave] = u;
        __syncthreads();
        if (tid == 0) {
            unsigned un = 0u;
            for (int w = 0; w < NWAVES; ++w) un |= ((LAS unsigned*)(lds + MB_UN))[w];
            LAS unsigned short* tl = (LAS unsigned short*)(lds + MB_TL); int cnt = 0;
            for (int kt = 0; kt < 4; ++kt) tl[cnt++] = (unsigned short)(own * MOBA_BLK + 64 * kt);
            for (int j = own - 1; j >= 0 && own - j <= reach; --j) if ((un >> j) & 1u) for (int kt = 0; kt < 4; ++kt) tl[cnt++] = (unsigned short)(j * MOBA_BLK + 64 * kt);
            ((LAS unsigned*)(lds + MB_UN))[8] = (unsigned)cnt;
        }
        __syncthreads();
    }
    const int ntiles_all = (int)((LAS unsigned*)(lds + MB_UN))[8];
    const int tper = (ntiles_all + npieces - 1) / npieces, t_lo = piece * tper, ntiles = min(ntiles_all, t_lo + tper);
    const LAS unsigned short* tl = (const LAS unsigned short*)(lds + MB_TL);
    const bf16* kbase = PG(P, G_MK + h) + (size_t)b * T * HD; const bf16* vbase = PG(P, G_MV + h) + (size_t)b * T * HD;
    v4u pvv[2];
#define MB_LOAD(kp0, bufn) do { _Pragma("unroll") for (int u = 0; u < 2; ++u) { const int p = tid + NTHREADS * u, row = p >> 4, sl = p & 15; \
        __builtin_amdgcn_global_load_lds((const unsigned*)(kbase + (size_t)((kp0) + row) * HD + ((sl ^ (row & 15)) * 8)), (LAS unsigned*)(lds + MB_K0 + (bufn) * 16384 + wave * 1024 + u * 8192), 16, 0, 0); \
        pvv[u] = *(const v4u*)(vbase + (size_t)((kp0) + lane) * HD + (wave + 8 * u) * 8); } } while (0)
#define MB_STORE(buf) do { _Pragma("unroll") for (int u = 0; u < 2; ++u) { \
        const unsigned w4[4] = {pvv[u].x, pvv[u].y, pvv[u].z, pvv[u].w}; const int pcv = wave + 8 * u; \
        _Pragma("unroll") for (int jj = 0; jj < 8; ++jj) *(LAS unsigned short*)(lds + MB_V0 + (buf) * MB_VSZ + (pcv * 8 + jj) * 136 + lane * 2) = (unsigned short)((jj & 1) ? (w4[jj >> 1] >> 16) : (w4[jj >> 1] & 0xffffu)); } } while (0)
    if (t_lo < ntiles) { MB_LOAD((int)tl[t_lo], t_lo & 1); MB_STORE(t_lo & 1); }
    asm volatile("s_waitcnt vmcnt(0)" ::: "memory");
    __syncthreads();
    const f32x2v cA = {0.f, c2}, cB = {2.f * c2, 3.f * c2};
    f32x16 O[4];
#pragma unroll
    for (int et = 0; et < 4; ++et)
#pragma unroll
        for (int r = 0; r < 16; ++r) O[et][r] = 0.f;
    asm volatile("" :: "v"(Qf[0]), "v"(Qf[1]), "v"(Qf[2]), "v"(Qf[3]), "v"(Qf[4]), "v"(Qf[5]), "v"(Qf[6]), "v"(Qf[7]));
    float mrun = -1e30f, lsum = 0.f;
#pragma unroll 1
    for (int ti = t_lo; ti < ntiles; ++ti) {
        const int kp0 = (int)tl[ti], buf = ti & 1;
        { const int tn = (ti + 1 < ntiles) ? ti + 1 : ti; MB_LOAD((int)tl[tn], buf ^ 1); }
        const int blk = kp0 >> 8; const bool isown = (blk == own);
        const bool rowact = isown ? true : (((selmask >> blk) & 1u) != 0u);
        const bool wave_on = isown ? (kp0 <= tq0 + 32 * wave + 31) : (__ballot(rowact) != 0ull);
        if (wave_on) {
            const float moff = (mrun < -1e29f) ? 0.f : mrun;
            f32x16 sc[2];
#pragma unroll
            for (int sub = 0; sub < 2; ++sub) {
#pragma unroll
                for (int r = 0; r < 16; ++r) sc[sub][r] = 0.f;
                const int row = 32 * sub + ql; const LAS unsigned char* kb = lds + MB_K0 + buf * 16384 + row * 256;
#pragma unroll
                for (int ks = 0; ks < 8; ++ks) sc[sub] = MFMA32(*(const LAS bf16x8*)(kb + (((2 * ks + hh) ^ (row & 15)) << 4)), Qf[ks], sc[sub]);
            }
            float mt = NEG;
#pragma unroll
            for (int sub = 0; sub < 2; ++sub) {
                const int kb0 = kp0 + 32 * sub + 4 * hh; const float binit = rowact ? c2 * (float)(kb0 - tq0) - moff : NEG;
#pragma unroll
                for (int j = 0; j < 4; ++j) {
                    const float aj = c2 * (float)(8 * j) + binit; const f32x2v a2 = {aj, aj};
                    f32x2v v01 = (f32x2v){sc[sub][4 * j], sc[sub][4 * j + 1]} + (a2 + cA), v23 = (f32x2v){sc[sub][4 * j + 2], sc[sub][4 * j + 3]} + (a2 + cB);
                    if (isown) { const int kk0 = kb0 + 8 * j; v01.x = (kk0 <= tq) ? v01.x : NEG; v01.y = (kk0 + 1 <= tq) ? v01.y : NEG; v23.x = (kk0 + 2 <= tq) ? v23.x : NEG; v23.y = (kk0 + 3 <= tq) ? v23.y : NEG; }
                    sc[sub][4 * j] = v01.x; sc[sub][4 * j + 1] = v01.y; sc[sub][4 * j + 2] = v23.x; sc[sub][4 * j + 3] = v23.y;
                    mt = fmaxf(mt, v01.x); mt = fmaxf(mt, v01.y); mt = fmaxf(mt, v23.x); mt = fmaxf(mt, v23.y); }
            }
            mt = fmaxf(mt, __shfl_xor(mt, 32));
            if (__any(mt + moff > mrun + 6.0f)) {
                const float mnew = fmaxf(mrun, mt + moff), alpha = __builtin_amdgcn_exp2f(mrun - mnew), dlt = mnew - moff;
#pragma unroll
                for (int et = 0; et < 4; ++et) O[et] = O[et] * alpha;
                lsum *= alpha; mrun = mnew;
#pragma unroll
                for (int sub = 0; sub < 2; ++sub) sc[sub] = sc[sub] - dlt; }
            {   f32x2v pa = {0.f, 0.f}, pb = {0.f, 0.f};
#pragma unroll
                for (int r = 0; r < 16; r += 2) { const float p0 = __builtin_amdgcn_exp2f(sc[0][r]), p1 = __builtin_amdgcn_exp2f(sc[0][r + 1]), p2 = __builtin_amdgcn_exp2f(sc[1][r]), p3 = __builtin_amdgcn_exp2f(sc[1][r + 1]);
                    sc[0][r] = p0; sc[0][r + 1] = p1; sc[1][r] = p2; sc[1][r + 1] = p3; pa += (f32x2v){p0, p1}; pb += (f32x2v){p2, p3}; }
                pa += pb; lsum += pa.x + pa.y; }
            bf16x8 Pb[4];
#pragma unroll
            for (int kk = 0; kk < 4; ++kk) { const int sub = kk >> 1, s2 = kk & 1; v4u pp;
                pp.x = pkbf(sc[sub][8 * s2], sc[sub][8 * s2 + 1]); pp.y = pkbf(sc[sub][8 * s2 + 2], sc[sub][8 * s2 + 3]); pp.z = pkbf(sc[sub][8 * s2 + 4], sc[sub][8 * s2 + 5]); pp.w = pkbf(sc[sub][8 * s2 + 6], sc[sub][8 * s2 + 7]);
                Pb[kk] = __builtin_bit_cast(bf16x8, pp); }
#pragma unroll
            for (int et = 0; et < 4; ++et) { const LAS unsigned char* vb = lds + MB_V0 + buf * MB_VSZ + (32 * et + ql) * 136 + 8 * hh;
#pragma unroll
                for (int kk = 0; kk < 4; ++kk) { const s16x4 lo = *(const volatile LAS s16x4*)(vb + 32 * kk), hi = *(const volatile LAS s16x4*)(vb + 32 * kk + 16);
                    O[et] = MFMA32(__builtin_shufflevector(lo, hi, 0, 1, 2, 3, 4, 5, 6, 7), Pb[kk], O[et]); } }
        }
        if (ti + 1 < ntiles) MB_STORE(buf ^ 1);
        asm volatile("s_waitcnt vmcnt(0)" ::: "memory");
        __syncthreads();
    }
#undef MB_LOAD
#undef MB_STORE
    if (npieces > 1) {
        float* part = (float*)(a.ws + WS_MBP) + (size_t)(slot * 2) * 66 * NTHREADS;
        float* mine = part + (size_t)piece * 66 * NTHREADS + tid;
#pragma unroll
        for (int et = 0; et < 4; ++et)
#pragma unroll
            for (int r = 0; r < 16; ++r) mine[(size_t)(16 * et + r) * NTHREADS] = O[et][r];
        mine[(size_t)64 * NTHREADS] = mrun; mine[(size_t)65 * NTHREADS] = lsum;
        asm volatile("s_waitcnt vmcnt(0)" ::: "memory");
        __syncthreads();
        if (tid == 0) {
            __builtin_amdgcn_fence(__ATOMIC_RELEASE, "agent");
            asm volatile("s_waitcnt vmcnt(0)" ::: "memory");
            const unsigned old = __hip_atomic_fetch_add((unsigned*)(a.ws + WS_CTL) + CW_MBCNT + 128 * l + slot, 1u, __ATOMIC_RELAXED, __HIP_MEMORY_SCOPE_AGENT);
            if (old == (unsigned)(npieces - 1)) { __builtin_amdgcn_fence(__ATOMIC_ACQUIRE, "agent"); asm volatile("s_waitcnt vmcnt(0)" ::: "memory"); }
            ((LAS unsigned*)(lds + MB_UN))[9] = old;
        }
        __syncthreads();
        if (((LAS unsigned*)(lds + MB_UN))[9] != (unsigned)(npieces - 1)) return;
        const float* oth = part + (size_t)(piece ^ 1) * 66 * NTHREADS + tid;
        const float mo = oth[(size_t)64 * NTHREADS], lo = oth[(size_t)65 * NTHREADS];
        const float mm = fmaxf(mrun, mo), fa = __builtin_amdgcn_exp2f(mrun - mm), fb = __builtin_amdgcn_exp2f(mo - mm);
        lsum = lsum * fa + lo * fb;
#pragma unroll
        for (int et = 0; et < 4; ++et) { float ot[16];
#pragma unroll
            for (int r = 0; r < 16; ++r) ot[r] = oth[(size_t)(16 * et + r) * NTHREADS];
#pragma unroll
            for (int r = 0; r < 16; ++r) O[et][r] = O[et][r] * fa + ot[r] * fb; }
    }
    lsum += __shfl_xor(lsum, 32);
    const float inv = 1.0f / lsum;
    uint2 zall[16];
#pragma unroll
    for (int i = 0; i < 16; ++i) zall[i] = *(const uint2*)(PG(P, G_MZ + h) + mrow * HD + 32 * (i >> 2) + 8 * (i & 3) + 4 * hh);
#pragma unroll
    for (int et = 0; et < 4; ++et)
#pragma unroll
        for (int g = 0; g < 4; ++g) { const int e = 32 * et + 8 * g + 4 * hh;
            const uint2 zu = zall[4 * et + g];
            uint2 yo; yo.x = pkbf(O[et][4 * g] * inv * silu_fast(bflo(zu.x)), O[et][4 * g + 1] * inv * silu_fast(bfhi(zu.x)));
            yo.y = pkbf(O[et][4 * g + 2] * inv * silu_fast(bflo(zu.y)), O[et][4 * g + 3] * inv * silu_fast(bfhi(zu.y)));
            *(uint2*)(Y + mrow * DM + 1280 + h * HD + e) = yo; }
}
constexpr int PH_PER_LAYER = 6, N_PHASES = DEPTH * PH_PER_LAYER;
__global__ void __launch_bounds__(NTHREADS, 2) hymba_fwd(Args args) {
    extern __shared__ __attribute__((aligned(16))) unsigned char lds_raw[];
    LAS unsigned char* lds = (LAS unsigned char*)lds_raw;
    {   const int tid0 = threadIdx.x;
        for (int u = tid0; u < (LDS_BYTES - LDSCTL_OFF) / 4; u += NTHREADS) ((LAS unsigned*)(lds + LDSCTL_OFF))[u] = 0u; }
    __syncthreads();
    XcdBarrier bar = xcd_barrier_post((unsigned*)(args.ws + WS_CTL) + CW_BAR, (volatile LAS unsigned*)(lds + MISC_OFF) + 8);
    const int lo = args.ph_lo, hi = args.ph_hi;
#ifndef DUP_PHASE
#define DUP_PHASE -1
#endif
    int dup_done = 0;
#pragma unroll 1
    for (int ph = lo; ph < hi; ++ph) {
        const int l = ph / PH_PER_LAYER, k = ph - l * PH_PER_LAYER;
        Args A = args;
{ size_t zoff = 0; asm volatile("" : "+s"(zoff)); A.ws = args.ws + zoff; A.out = args.out + zoff; }
        int tid = threadIdx.x; asm volatile("" : "+v"(tid));
        const int lane = tid & 63, wave = __builtin_amdgcn_readfirstlane(tid >> 6);
        const int G = gridDim.x; int bx = blockIdx.x; asm volatile("" : "+s"(bx));
        const int vcu = (G % 8 == 0) ? (bx % 8) * (G / 8) + bx / 8 : bx;
        const int gw = vcu * NWAVES + wave, NGW = G * NWAVES;
        const float* xin = (l == 0) ? A.in[0] : A.out;
        switch (k) {
        case 0: { p0_weights(A, l, lds, gw, NGW, wave, lane); p0_rows(A, l, xin, lds, gw, NGW, tid, lane); } break;
        case 1: {
            pg8::Gemm g{(const bf16*)(A.ws + WS_H), (const bf16*)(A.ws + WS_WIN), M, NP, DM}; pg8::StaticOrder S; S.init(M, NP, G, bx);
            pg8::EpiBf16 E{(bf16*)(A.ws + WS_PROJ), 0, 0u};
            pg8::gemm_phase<pg8::EpiBf16, pg8::StaticOrder, false, true>(lds + RING_OFF, g, S, E, tid);
        } break;
        case 2: {
            unsigned* qctr = (unsigned*)(A.ws + WS_CTL) + CW_QUEUE + 64 * l + 16 + 1024 * dup_done;
            __syncthreads();
            if (tid == 0) ((LAS unsigned*)(lds + B_END))[0] = __hip_atomic_fetch_add(qctr, 1u, __ATOMIC_RELAXED, __HIP_MEMORY_SCOPE_AGENT);
            __syncthreads();
            int item = (int)((LAS unsigned*)(lds + B_END))[0];
#pragma unroll 1
            while (item < BATCH * MOBA_NB + BATCH * NSH * NCH) {
                int t2 = threadIdx.x; asm volatile("" : "+v"(t2));
                const int lane2 = t2 & 63, wave2 = __builtin_amdgcn_readfirstlane(t2 >> 6);
                unsigned nxt = 0u;
                if (item < BATCH * MOBA_NB) { mp_item(A, l, item, lds, t2, lane2, wave2); if (t2 == 0) nxt = __hip_atomic_fetch_add(qctr, 1u, __ATOMIC_RELAXED, __HIP_MEMORY_SCOPE_AGENT); }
                else sa_item(A, l, item - BATCH * MOBA_NB, lds, t2, lane2, wave2, qctr, nxt);
                if (t2 == 0) ((LAS unsigned*)(lds + B_END))[0] = nxt;
                __syncthreads();
                item = (int)((LAS unsigned*)(lds + B_END))[0];
            }
        } break;
        case 3: {
            if (bx < 4 * BATCH * GH) {
                const int di = bx >> 2, sh = (di / GH) * NSH + RH + di % GH, seg = (bx >> 1) & 1, nfull = seg ? SB_SPLIT : 0, nend = seg ? NCH : SB_SPLIT;
                sb_item<true>(A, l, sh, bx & 1, nfull, nend, lds, tid, lane, wave);
            } else if (bx < 4 * BATCH * GH + 2 * BATCH * RH) {
                const int ri = (bx - 4 * BATCH * GH) >> 1, sh = (ri / RH) * NSH + ri % RH;
                sb_item<false>(A, l, sh, bx & 1, 0, NCH, lds, tid, lane, wave); }
            unsigned* qctr = (unsigned*)(A.ws + WS_CTL) + CW_QUEUE + 64 * l + 1024 * dup_done;
            for (;;) {
                __syncthreads();
                if (tid == 0) ((LAS unsigned*)(lds + B_END))[0] = __hip_atomic_fetch_add(qctr, 1u, __ATOMIC_RELAXED, __HIP_MEMORY_SCOPE_AGENT);
                __syncthreads();
                const int item = (int)((LAS unsigned*)(lds + B_END))[0];
                if (item >= MB_ITEMS) break;
                int t2 = threadIdx.x; asm volatile("" : "+v"(t2));
                const int lane2 = t2 & 63, wave2 = __builtin_amdgcn_readfirstlane(t2 >> 6);
                mb_item(A, l, item, lds, t2, lane2, wave2);
            }
        } break;
        case 4: fx_rows(A, l, gw, NGW, lane); break;
        default: {
            pg8::Gemm g{(const bf16*)(A.ws + WS_Y), (const bf16*)(A.ws + WS_WOUT), M, DM, DM}; pg8::StaticOrder S; S.init(M, DM, G, bx);
            pg8::EpiResF32 E{A.out, xin, DM};
            pg8::gemm_phase<pg8::EpiResF32, pg8::StaticOrder, false, true>(lds + RING_OFF, g, S, E, tid);
        } break;
        }
        if (DUP_PHASE >= 0 && ph == DUP_PHASE && !dup_done) { dup_done = 1; xcd_barrier(bar); --ph; continue; }
        if (ph + 1 < hi) xcd_barrier(bar);
    }
}

#ifndef RUN_PHASES
#define RUN_PHASES N_PHASES
#endif
#ifndef MK_N_LAUNCHES
#define MK_N_LAUNCHES 1
#endif
extern "C" void kernel_launch(void* const* d_in, const int* in_sizes, int n_in, void* d_out, int out_size, void* d_ws, size_t ws_size, hipStream_t stream) {
    static int grid = 0;
    if (grid == 0) {
        if (n_in != 11 || in_sizes[0] != M * DM || out_size != M * DM || ws_size < WS_END) { fprintf(stderr, "kernel_launch: unexpected shapes (n_in %d, in0 %d, out %d, ws %zu)\n", n_in, n_in > 0 ? in_sizes[0] : -1, out_size, ws_size); grid = -1; return; }
        int dev = 0, cus = 0, per_cu = 0;
        if (hipGetDevice(&dev) != hipSuccess || hipDeviceGetAttribute(&cus, hipDeviceAttributeMultiprocessorCount, dev) != hipSuccess) { grid = -1; return; }
        if (hipFuncSetAttribute((const void*)hymba_fwd, hipFuncAttributeMaxDynamicSharedMemorySize, LDS_BYTES) != hipSuccess) { fprintf(stderr, "kernel_launch: hipFuncSetAttribute failed\n"); grid = -1; return; }
        if (hipOccupancyMaxActiveBlocksPerMultiprocessor(&per_cu, (const void*)hymba_fwd, NTHREADS, LDS_BYTES) != hipSuccess || per_cu < 1) fprintf(stderr, "kernel_launch: occupancy query says %d\n", per_cu);
        (void)hipGetLastError();
        grid = cus;
    }
    if (grid < 0) return;
    (void)hipMemsetAsync((char*)d_ws + WS_CTL, 0, CTL_ZERO_BYTES, stream);
    Args a{};
    for (int i = 0; i < 11; ++i) a.in[i] = (const float*)d_in[i];
    a.out = (float*)d_out; a.ws = (unsigned char*)d_ws;
    constexpr int NL = MK_N_LAUNCHES;
    for (int li = 0; li < NL; ++li) {
        a.ph_lo = (NL == 1) ? 0 : li; a.ph_hi = (NL == 1) ? RUN_PHASES : li + 1;
        hipLaunchKernelGGL(hymba_fwd, dim3(grid), dim3(NTHREADS), LDS_BYTES, stream, a);
    }
}
```
